# Optimizing an MI355X kernel written in HIP

```python
import math
import jax, jax.numpy as jnp
from jax import lax
import numpy as np

D_MODEL = 4096
BATCH = 2
SEQ = 4096
DEPTH = 1

HEAD_DIM = 128
MIX_WIDTH = D_MODEL
A_HEADS = MIX_WIDTH // (2 * HEAD_DIM)
A_KV_HEADS = A_HEADS // 4
A_GROUP = A_HEADS // A_KV_HEADS
DILATED_BRANCHES = ((128, 1), (512, 4), (2048, 16))
B_HEADS = MIX_WIDTH // (2 * HEAD_DIM)
IDX_HEADS = 16
IDX_DIM = 64
DSA_TOPK_MAX = 256
Q_BLK = 128
PEER_HEADS = 8
PEER_NKEYS = 128
PEER_EXPERTS = PEER_NKEYS * PEER_NKEYS
PEER_QDIM = 256
PEER_HALF = PEER_QDIM // 2
PEER_TOPK = 16
PEER_TOK_BLK = 32
ROPE_THETA = 10000.0
NORM_EPS = 1e-6
NEG = -1e30
ADA_CHUNKS = 6

QA_COLS = A_HEADS * HEAD_DIM
KA_COLS = A_KV_HEADS * HEAD_DIM
VA_COLS = A_KV_HEADS * HEAD_DIM
QB_COLS = B_HEADS * HEAD_DIM
KB_COLS = HEAD_DIM
VB_COLS = HEAD_DIM
QI_COLS = IDX_HEADS * IDX_DIM
KI_COLS = IDX_DIM
WI_COLS = IDX_HEADS
IN_COLS = QA_COLS + KA_COLS + VA_COLS + QB_COLS + KB_COLS + VB_COLS + QI_COLS + KI_COLS + WI_COLS
IN_SPLITS = (QA_COLS,
             QA_COLS + KA_COLS,
             QA_COLS + KA_COLS + VA_COLS,
             QA_COLS + KA_COLS + VA_COLS + QB_COLS,
             QA_COLS + KA_COLS + VA_COLS + QB_COLS + KB_COLS,
             QA_COLS + KA_COLS + VA_COLS + QB_COLS + KB_COLS + VB_COLS,
             QA_COLS + KA_COLS + VA_COLS + QB_COLS + KB_COLS + VB_COLS + QI_COLS,
             QA_COLS + KA_COLS + VA_COLS + QB_COLS + KB_COLS + VB_COLS + QI_COLS + KI_COLS)

kernel_name = "hybrid_dilated_dsa_peer_block"


def rms_norm(x, g):
    xf = x.astype(jnp.float32)
    y = xf * lax.rsqrt(jnp.mean(xf * xf, axis=-1, keepdims=True) + NORM_EPS)
    return (y * g.astype(jnp.float32)).astype(x.dtype)


def rope_tables(positions, dim):
    inv = jnp.power(ROPE_THETA, -jnp.arange(0, dim, 2, dtype=jnp.float32) / dim)
    ang = positions.astype(jnp.float32)[..., None] * inv
    return jnp.cos(ang)[:, :, None, :], jnp.sin(ang)[:, :, None, :]


def apply_rope(t, cos, sin):
    tf = t.astype(jnp.float32)
    half = t.shape[-1] // 2
    t1, t2 = tf[..., :half], tf[..., half:]
    return jnp.concatenate([t1 * cos - t2 * sin, t2 * cos + t1 * sin], axis=-1).astype(t.dtype)


def dilated_branch(q, k, v, window, dil):
    b_, s_, kvh, grp, dh = q.shape
    blk = window // dil
    span = dil * blk
    s_pad = -(-s_ // span) * span
    pad = s_pad - s_
    m = s_pad // dil
    nb = m // blk

    def split(t):
        t = jnp.pad(t, [(0, 0), (0, pad)] + [(0, 0)] * (t.ndim - 2))
        t = t.reshape((b_, m, dil) + t.shape[2:])
        t = jnp.moveaxis(t, 2, 1)
        return t.reshape((b_, dil, nb, blk) + t.shape[3:])

    def with_prev(t):
        prev = jnp.pad(t, [(0, 0), (0, 0), (1, 0)] + [(0, 0)] * (t.ndim - 3))[:, :, :-1]
        return jnp.concatenate([prev, t], axis=3)

    qs = split(q)
    kc = with_prev(split(k))
    vc = with_prev(split(v))
    s = jnp.einsum('brnqkgd,brnjkd->brnkgqj', qs, kc).astype(jnp.float32) * (dh ** -0.5)
    qi = jnp.arange(blk)[:, None]
    kj = jnp.arange(2 * blk)[None, :]
    dist = qi + blk - kj
    band = (dist >= 0) & (dist <= blk)
    first = (jnp.arange(nb) == 0)[:, None, None]
    mask = band[None] & ~(first & (kj < blk)[None])
    s = jnp.where(mask[None, None, :, None, None], s, NEG)
    mx = jnp.max(s, axis=-1, keepdims=True)
    p = jnp.exp(s - mx)
    l = jnp.sum(p, axis=-1, keepdims=True)
    o = jnp.einsum('brnkgqj,brnjkd->brnqkgd', (p / l).astype(v.dtype), vc)
    lse = jnp.moveaxis((mx + jnp.log(l))[..., 0], -1, 3)

    def merge(t):
        t = t.reshape((b_, dil, m) + t.shape[4:])
        t = jnp.moveaxis(t, 1, 2)
        return t.reshape((b_, s_pad) + t.shape[3:])[:, :s_]

    return merge(o), merge(lse)


def dilated_mixture(q, k, v):
    b_, s_ = q.shape[:2]
    qg = q.reshape(b_, s_, A_KV_HEADS, A_GROUP, HEAD_DIM)
    outs, lses = [], []
    for window, dil in DILATED_BRANCHES:
        o, lse = dilated_branch(qg, k, v, window, dil)
        outs.append(o)
        lses.append(lse)
    wts = jax.nn.softmax(jnp.stack(lses, axis=0), axis=0)
    o = jnp.einsum('ibskg,ibskgd->bskgd', wts.astype(q.dtype), jnp.stack(outs, axis=0))
    return o.reshape(b_, s_, A_HEADS * HEAD_DIM)


def dsa_attention(q, k, v, qi, ki, wi):
    b_, s_ = q.shape[:2]
    topk = min(DSA_TOPK_MAX, s_ // 4)
    nb = s_ // Q_BLK

    def blocks(t):
        return jnp.moveaxis(t.reshape((b_, nb, Q_BLK) + t.shape[2:]), 1, 0)

    tpos = jnp.arange(s_, dtype=jnp.int32).reshape(nb, Q_BLK)
    key_pos = jnp.arange(s_, dtype=jnp.int32)
    ki_f = ki.astype(jnp.float32)

    def one_block(args):
        qb, qib, wib, tb = args
        rel = jax.nn.relu(jnp.einsum('bqhd,bsd->bqhs', qib.astype(jnp.float32), ki_f) * (IDX_DIM ** -0.5))
        score = jnp.einsum('bqh,bqhs->bqs', wib.astype(jnp.float32) * (IDX_HEADS ** -0.5), rel)
        causal = key_pos[None, :] <= tb[:, None]
        score = jnp.where(causal[None], score, -jnp.inf)
        _, sel = lax.top_k(score, topk)
        flat = sel.reshape(b_, -1, 1)
        kg = jnp.take_along_axis(k, flat, axis=1).reshape(b_, Q_BLK, topk, HEAD_DIM)
        vg = jnp.take_along_axis(v, flat, axis=1).reshape(b_, Q_BLK, topk, HEAD_DIM)
        s = jnp.einsum('bqhd,bqkd->bqhk', qb, kg).astype(jnp.float32) * (HEAD_DIM ** -0.5)
        valid = sel <= tb[None, :, None]
        s = jnp.where(valid[:, :, None, :], s, NEG)
        p = jax.nn.softmax(s, axis=-1).astype(vg.dtype)
        return jnp.einsum('bqhk,bqkd->bqhd', p, vg)

    out = lax.map(one_block, (blocks(q), blocks(qi), blocks(wi), tpos))
    return jnp.moveaxis(out, 0, 1).reshape(b_, s_, B_HEADS * HEAD_DIM)


def mixing(h, positions, w_in, w_out):
    b_, s_, _ = h.shape
    proj = h @ w_in
    qa, ka, va, qb, kb, vb, qi, ki, wi = jnp.split(proj, IN_SPLITS, axis=-1)
    cos_h, sin_h = rope_tables(positions, HEAD_DIM)
    cos_i, sin_i = rope_tables(positions, IDX_DIM)
    qa = apply_rope(qa.reshape(b_, s_, A_HEADS, HEAD_DIM), cos_h, sin_h)
    ka = apply_rope(ka.reshape(b_, s_, A_KV_HEADS, HEAD_DIM), cos_h, sin_h)
    va = va.reshape(b_, s_, A_KV_HEADS, HEAD_DIM)
    o_a = dilated_mixture(qa, ka, va)
    qb = apply_rope(qb.reshape(b_, s_, B_HEADS, HEAD_DIM), cos_h, sin_h)
    kb = apply_rope(kb[:, :, None, :], cos_h, sin_h)[:, :, 0]
    qi = apply_rope(qi.reshape(b_, s_, IDX_HEADS, IDX_DIM), cos_i, sin_i)
    ki = apply_rope(ki[:, :, None, :], cos_i, sin_i)[:, :, 0]
    o_b = dsa_attention(qb, kb, vb, qi, ki, wi)
    return jnp.concatenate([o_a, o_b], axis=-1) @ w_out


def peer(h, w_q, sub_keys, u_tab, v_tab):
    b_, s_, d = h.shape
    t_ = b_ * s_
    x = h.reshape(t_, d)
    q = (x @ w_q).reshape(t_, PEER_HEADS, 2, PEER_HALF).astype(jnp.float32)
    s = jnp.einsum('thpc,hpnc->thpn', q, sub_keys.astype(jnp.float32))
    v_half, i_half = lax.top_k(s, PEER_TOPK)
    cand = v_half[:, :, 0, :, None] + v_half[:, :, 1, None, :]
    cand_idx = i_half[:, :, 0, :, None] * PEER_NKEYS + i_half[:, :, 1, None, :]
    top_s, pos = lax.top_k(cand.reshape(t_, PEER_HEADS, -1), PEER_TOPK)
    experts = jnp.take_along_axis(cand_idx.reshape(t_, PEER_HEADS, -1), pos, axis=-1)
    gates = jax.nn.softmax(top_s, axis=-1)
    nbk = t_ // PEER_TOK_BLK

    def one_block(args):
        xb, eb, gb = args
        u = jnp.take(u_tab, eb, axis=0)
        a = jnp.einsum('td,thkd->thk', xb, u).astype(jnp.float32)
        act = (jax.nn.gelu(a, approximate=False) * gb).astype(xb.dtype)
        vv = jnp.take(v_tab, eb, axis=0)
        return jnp.einsum('thk,thkd->td', act, vv)

    out = lax.map(one_block, (x.reshape(nbk, PEER_TOK_BLK, d),
                              experts.reshape(nbk, PEER_TOK_BLK, PEER_HEADS, PEER_TOPK),
                              gates.reshape(nbk, PEER_TOK_BLK, PEER_HEADS, PEER_TOPK)))
    return out.reshape(b_, s_, d)


def setup_inputs(seed: int = 0) -> dict:
    key = jax.random.key(seed)
    ks = jax.random.split(key, 16)
    f32 = jnp.float32
    x = jax.random.normal(ks[0], (BATCH, SEQ, D_MODEL), f32)
    c = jax.random.normal(ks[1], (BATCH, D_MODEL), f32)
    offsets = jax.random.randint(ks[2], (BATCH, 1), 0, 1024, dtype=jnp.int32)
    positions = offsets + jnp.arange(SEQ, dtype=jnp.int32)[None, :]
    ln1_g = 1.0 + 0.01 * jax.random.normal(ks[3], (DEPTH, D_MODEL), f32)
    ln2_g = 1.0 + 0.01 * jax.random.normal(ks[4], (DEPTH, D_MODEL), f32)
    w_ada = 0.5 * (D_MODEL ** -0.5) * jax.random.normal(ks[5], (DEPTH, D_MODEL, ADA_CHUNKS * D_MODEL), f32)
    b_ada = 0.02 * jax.random.normal(ks[6], (DEPTH, ADA_CHUNKS * D_MODEL), f32)
    w_in = (D_MODEL ** -0.5) * jax.random.normal(ks[7], (DEPTH, D_MODEL, IN_COLS), f32)
    w_out = (MIX_WIDTH ** -0.5) * jax.random.normal(ks[8], (DEPTH, MIX_WIDTH, D_MODEL), f32)
    peer_wq = (D_MODEL ** -0.5) * jax.random.normal(ks[9], (DEPTH, D_MODEL, PEER_HEADS * PEER_QDIM), f32)
    peer_sub_keys = (PEER_HALF ** -0.5) * jax.random.normal(ks[10], (DEPTH, PEER_HEADS, 2, PEER_NKEYS, PEER_HALF), f32)
    peer_u = (D_MODEL ** -0.5) * jax.random.normal(ks[11], (DEPTH, PEER_EXPERTS, D_MODEL), f32)
    peer_v = (PEER_HEADS ** -0.5) * jax.random.normal(ks[12], (DEPTH, PEER_EXPERTS, D_MODEL), f32)
    lnf_g = 1.0 + 0.01 * jax.random.normal(ks[13], (D_MODEL,), f32)
    return {"x": x, "c": c, "positions": positions, "ln1_g": ln1_g, "ln2_g": ln2_g,
            "w_ada": w_ada, "b_ada": b_ada, "w_in": w_in, "w_out": w_out,
            "peer_wq": peer_wq, "peer_sub_keys": peer_sub_keys, "peer_u": peer_u,
            "peer_v": peer_v, "lnf_g": lnf_g}


def reference(x, c, positions, ln1_g, ln2_g, w_ada, b_ada, w_in, w_out,
              peer_wq, peer_sub_keys, peer_u, peer_v, lnf_g):
    for layer in range(DEPTH):
        mod = jax.nn.silu(c) @ w_ada[layer] + b_ada[layer]
        shift1, scale1, gate1, shift2, scale2, gate2 = [m[:, None, :] for m in jnp.split(mod, ADA_CHUNKS, axis=-1)]
        h = rms_norm(x, ln1_g[layer]) * (1.0 + scale1) + shift1
        x = x + gate1 * mixing(h, positions, w_in[layer], w_out[layer])
        h = rms_norm(x, ln2_g[layer]) * (1.0 + scale2) + shift2
        x = x + gate2 * peer(h, peer_wq[layer], peer_sub_keys[layer], peer_u[layer], peer_v[layer])
    return rms_norm(x, lnf_g)
```

```cpp
#include <hip/hip_runtime.h>
#include <cstdio>
#include <cstdint>
namespace pg8 {
#define PG8_LAS __attribute__((address_space(3)))
typedef unsigned short bf16_t;
typedef short bf16x8 __attribute__((ext_vector_type(8)));
typedef float f32x4 __attribute__((ext_vector_type(4)));
typedef unsigned u32x4 __attribute__((ext_vector_type(4)));
constexpr int BM = 256, BK = 64, HALF = 128, HTB = HALF * BK * 2  , STAGE_BYTES = 8 * HTB, NXCD = 8, WGM = 8;

__host__ __device__ __forceinline__ int lds_byte(int r, int c) { const int st = (r >> 4) * 2 + (c >> 5), rr = r & 15, cc = c & 31, ob = rr * 64 + cc * 2; return st * 1024 + (ob ^ (((ob >> 9) & 1) << 5)); }
__host__ __device__ __forceinline__ void stage_rc(int b, int& R, int& C) { const int st = b / 1024, sb = b % 1024, swz = sb ^ (((sb >> 9) & 1) << 5); R = (st >> 1) * 16 + swz / 64; C = (st & 1) * 32 + (swz % 64) / 2; }
__host__ __device__ __forceinline__ int perm32(int rho) { const int n = rho >> 4, i = rho & 15; return 8 * (i >> 2) + 4 * n + (i & 3); }

struct Unit { int pm, pn; };
struct Gemm { const bf16_t* A; const bf16_t* Bt; int M, N, K; };

struct StaticOrder {
    int nM, nN, nwg, G, c;
    __host__ __device__ void init(int M, int N, int G_, int c_) { nM = M / BM; nN = N / BM; nwg = nM * nN; G = G_; c = c_; }
    __host__ __device__ bool next(int i, Unit& u) const {
        const long L = (long)i * G + c; if (L >= nwg) return false;
        int wgid = (int)L; { const int q = nwg / NXCD, r = nwg % NXCD, xcd = wgid % NXCD, off = wgid / NXCD; wgid = (xcd < r ? xcd * (q + 1) : r * (q + 1) + (xcd - r) * q) + off; }
        const int nig = WGM * nN, gid = wgid / nig, fm = gid * WGM, gsz = (nM - fm) < WGM ? (nM - fm) : WGM;
        u.pm = fm + ((wgid % nig) % gsz); u.pn = (wgid % nig) / gsz; return true;
    }
    __device__ __forceinline__ void a_ready(const Unit&) const {}
    __device__ __forceinline__ void done(const Unit&) const {}
};

__device__ __forceinline__ unsigned cvt_pk_bf16(float lo, float hi) { unsigned r; asm volatile("v_cvt_pk_bf16_f32 %0, %1, %2" : "=v"(r) : "v"(lo), "v"(hi)); return r; }
typedef float f32x2 __attribute__((ext_vector_type(2)));
struct EpiStoreBf16 {
    static constexpr bool PERM = true, AFTER_DRAIN = false;
    bf16_t* O; int ldc;
    __device__ __forceinline__ void operator()(const f32x4 (&acc)[2][2][4][2], const Unit& u, int wr, int wc, int fr, int fq) const {
        const int row0 = u.pm * BM + wr * 64 + fr, col0 = u.pn * BM + wc * 32 + 8 * fq;
#pragma unroll
        for (int ai = 0; ai < 2; ++ai)
#pragma unroll
            for (int m = 0; m < 4; ++m) { bf16_t* rowp = O + (size_t)(row0 + ai * HALF + m * 16) * ldc + col0;
#pragma unroll
                for (int bj = 0; bj < 2; ++bj) { const f32x4 v0 = acc[ai][bj][m][0], v1 = acc[ai][bj][m][1];
                    u32x4 w; w.x = cvt_pk_bf16(v0[0], v0[1]); w.y = cvt_pk_bf16(v0[2], v0[3]); w.z = cvt_pk_bf16(v1[0], v1[1]); w.w = cvt_pk_bf16(v1[2], v1[3]);
                    *(u32x4*)(rowp + bj * HALF) = w; } }
    }
};
struct EpiProj {
    static constexpr bool PERM = true, AFTER_DRAIN = false;
    bf16_t* P; int ldc; const float* cosH; const float* sinH; const float* cosI; const float* sinI;
    __device__ __forceinline__ void operator()(const f32x4 (&acc)[2][2][4][2], const Unit& u, int wr, int wc, int fr, int fq) const {
        const int row0 = u.pm * BM + wr * 64 + fr;
#pragma unroll
        for (int bj = 0; bj < 2; ++bj) {
            const int c0 = u.pn * BM + bj * HALF + wc * 32 + 8 * fq;
            int type = 0, fo = 0;
            if (c0 < 2560 || (c0 >= 3072 && c0 < 5248)) { type = 1; fo = ((c0 & 127) >> 3) * 4; }
            else if (c0 >= 5376 && c0 < 6464) { type = 2; fo = ((c0 & 63) >> 3) * 4; }
#pragma unroll
            for (int ai = 0; ai < 2; ++ai)
#pragma unroll
                for (int m = 0; m < 4; ++m) { const int row = row0 + ai * HALF + m * 16;
                    f32x4 v0 = acc[ai][bj][m][0], v1 = acc[ai][bj][m][1];
                    if (type) { const float* ct = (type == 1) ? cosH + (size_t)row * 64 + fo : cosI + (size_t)row * 32 + fo;
                                const float* st = (type == 1) ? sinH + (size_t)row * 64 + fo : sinI + (size_t)row * 32 + fo;
                                const f32x4 cs = *(const f32x4*)ct, sn = *(const f32x4*)st;
                                const f32x4 lo = v0 * cs - v1 * sn, hi = v1 * cs + v0 * sn; v0 = lo; v1 = hi; }
                    u32x4 w; w.x = cvt_pk_bf16(v0[0], v0[1]); w.y = cvt_pk_bf16(v0[2], v0[3]); w.z = cvt_pk_bf16(v1[0], v1[1]); w.w = cvt_pk_bf16(v1[2], v1[3]);
                    *(u32x4*)(P + (size_t)row * ldc + c0) = w; }
        }
    }
};
struct EpiRes {
    static constexpr bool PERM = false, AFTER_DRAIN = false;
    const float* X; float* X1; int ldc; const float* modp; const float* bada; int chunk_off; int nada; int rows_per_batch_tile;
    __device__ __forceinline__ void operator()(const f32x4 (&acc)[2][2][4][2], const Unit& u, int wr, int wc, int fr, int fq) const {
        const int b = u.pm / rows_per_batch_tile;
        const int row0 = u.pm * BM + wr * 64 + fr;
#pragma unroll
        for (int bj = 0; bj < 2; ++bj)
#pragma unroll
            for (int n = 0; n < 2; ++n) { const int col = u.pn * BM + bj * HALF + wc * 32 + n * 16 + 4 * fq;
                f32x4 g = *(const f32x4*)(bada + chunk_off + col);
#pragma unroll
                for (int q = 0; q < 4; ++q) g += *(const f32x4*)(modp + (size_t)(q * 2 + b) * nada + chunk_off + col);
#pragma unroll
                for (int ai = 0; ai < 2; ++ai)
#pragma unroll
                    for (int m = 0; m < 4; ++m) { const size_t off = (size_t)(row0 + ai * HALF + m * 16) * ldc + col;
                        const f32x4 xv = *(const f32x4*)(X + off); *(f32x4*)(X1 + off) = xv + g * acc[ai][bj][m][n]; } }
    }
};
template <class Epi, class Sched, bool ALIGN_EPI = false, bool SP2 = false>
__device__ __forceinline__ void gemm_phase(PG8_LAS unsigned char* lds, const Gemm g, const Sched& S, const Epi& E) {
    const int tid = threadIdx.x, wid = __builtin_amdgcn_readfirstlane(tid >> 6), lane = tid & 63, wr = wid >> 2, wc = wid & 3, fr = lane & 15, fq = lane >> 4;
    const int K = g.K, nt = K / BK;
    unsigned voffA[2], voffB[2];
#pragma unroll
    for (int i = 0; i < 2; ++i) { int R, C; stage_rc(tid * 16 + i * 8192, R, C); const int Rb = Epi::PERM ? ((R & ~31) + perm32(R & 31)) : R;
        voffA[i] = (unsigned)(R * K + C) * 2u; voffB[i] = (unsigned)(Rb * K + C) * 2u; }
    const size_t kstep = (size_t)(BK * 2);
    const size_t hstep = (size_t)HALF * K * 2;
    const size_t tstep = 2 * hstep;
    const unsigned ldsw = (unsigned)wid * 1024u;
    const int aoff = lds_byte(wr * 64 + fr, fq * 8), boff = lds_byte(wc * 32 + fr, fq * 8);
#define PG8_SA(b, h) (((b) * 2 + (h)) * HTB)
#define PG8_SB(b, h) ((4 + (b) * 2 + (h)) * HTB)
#define PG8_STAGE(bufoff, gbase, voff) do { _Pragma("unroll") for (int _i = 0; _i < 2; ++_i) \
        __builtin_amdgcn_global_load_lds((const unsigned*)((const char*)(gbase) + (voff)[_i]), (PG8_LAS unsigned*)(lds + (bufoff) + ldsw + _i * 8192), 16, 0, 0); } while (0)
#define PG8_LDA(dst, b, h) do { _Pragma("unroll") for (int m = 0; m < 4; ++m) _Pragma("unroll") for (int k = 0; k < 2; ++k) dst[m][k] = *(const PG8_LAS bf16x8*)(lds + PG8_SA(b, h) + aoff + m * 2048 + k * 1024); } while (0)
#define PG8_LDB(dst, b, h) do { _Pragma("unroll") for (int n = 0; n < 2; ++n) _Pragma("unroll") for (int k = 0; k < 2; ++k) dst[n][k] = *(const PG8_LAS bf16x8*)(lds + PG8_SB(b, h) + boff + n * 2048 + k * 1024); } while (0)
#define PG8_MMA(ai, bj, At, Bt) do { __builtin_amdgcn_s_setprio(1); _Pragma("unroll") for (int m = 0; m < 4; ++m) _Pragma("unroll") for (int n = 0; n < 2; ++n) _Pragma("unroll") for (int k = 0; k < 2; ++k) \
        acc[ai][bj][m][n] = __builtin_amdgcn_mfma_f32_16x16x32_bf16(Bt[n][k], At[m][k], acc[ai][bj][m][n], 0, 0, 0); __builtin_amdgcn_s_setprio(0); } while (0)
#define PG8_WAIT_V(n) asm volatile("s_waitcnt vmcnt(" #n ")" ::: "memory")
#define PG8_WAIT_L(n) asm volatile("s_waitcnt lgkmcnt(" #n ")" ::: "memory")
#define PG8_BAR __builtin_amdgcn_s_barrier()
#define PG8_SCHED __builtin_amdgcn_sched_barrier(0)
    Unit cur, nxt; int ui = 0;
    if (!S.next(0, cur)) return;
    f32x4 acc[2][2][4][2];
#pragma unroll
    for (int a = 0; a < 2; ++a)
#pragma unroll
        for (int b = 0; b < 2; ++b)
#pragma unroll
            for (int m = 0; m < 4; ++m)
#pragma unroll
                for (int n = 0; n < 2; ++n) acc[a][b][m][n] = (f32x4){0.f, 0.f, 0.f, 0.f};
    bf16x8 At[4][2], B0[2][2], B1[2][2];
    const char* cA = (const char*)g.A + (size_t)cur.pm * tstep; const char* cB = (const char*)g.Bt + (size_t)cur.pn * tstep;
    S.a_ready(cur);
    if constexpr (SP2) {
        PG8_STAGE(PG8_SB(0, 0), cB, voffB); PG8_STAGE(PG8_SB(0, 1), cB + hstep, voffB); PG8_STAGE(PG8_SA(0, 0), cA, voffA); PG8_STAGE(PG8_SA(0, 1), cA + hstep, voffA);
        if (wr == 1) PG8_BAR;
        PG8_WAIT_V(2); PG8_BAR;
        PG8_STAGE(PG8_SB(1, 0), cB + kstep, voffB); PG8_STAGE(PG8_SA(1, 0), cA + kstep, voffA); PG8_STAGE(PG8_SB(1, 1), cB + hstep + kstep, voffB);
        PG8_WAIT_V(6); PG8_BAR;
    } else {
        PG8_STAGE(PG8_SB(0, 0), cB, voffB); PG8_STAGE(PG8_SA(0, 0), cA, voffA); PG8_STAGE(PG8_SB(0, 1), cB + hstep, voffB); PG8_STAGE(PG8_SA(0, 1), cA + hstep, voffA);
        if (wr == 1) PG8_BAR;
        PG8_WAIT_V(4); PG8_BAR;
        PG8_STAGE(PG8_SB(1, 0), cB + kstep, voffB); PG8_STAGE(PG8_SA(1, 0), cA + kstep, voffA); PG8_STAGE(PG8_SB(1, 1), cB + hstep + kstep, voffB);
        PG8_WAIT_V(6); PG8_BAR;
    }
    for (;;) {
        const bool has_next = S.next(ui + 1, nxt);
        const char* nA = has_next ? (const char*)g.A + (size_t)nxt.pm * tstep : cA; const char* nB = has_next ? (const char*)g.Bt + (size_t)nxt.pn * tstep : cB;
        for (int t = 0; t < nt; t += 2) {
            const bool last = (t == nt - 2);
            const char* a1 = cA + (size_t)(t + 1) * kstep;
            const char* a2 = last ? nA : cA + (size_t)(t + 2) * kstep; const char* b2 = last ? nB : cB + (size_t)(t + 2) * kstep;
            const char* a3 = a2 + kstep; const char* b3 = b2 + kstep;
            if (last && has_next) S.a_ready(nxt);
            if constexpr (SP2) {
            PG8_LDB(B0, 0, 0); PG8_LDB(B1, 0, 1); PG8_SCHED; PG8_LDA(At, 0, 0); PG8_STAGE(PG8_SA(1, 1), a1 + hstep, voffA);
            PG8_WAIT_V(8); PG8_WAIT_L(0); PG8_BAR; PG8_MMA(0, 0, At, B0); PG8_MMA(0, 1, At, B1); PG8_BAR; PG8_SCHED;
            PG8_LDA(At, 0, 1); PG8_STAGE(PG8_SB(0, 0), b2, voffB); PG8_STAGE(PG8_SB(0, 1), b2 + hstep, voffB); PG8_STAGE(PG8_SA(0, 0), a2, voffA);
            PG8_WAIT_V(8); PG8_WAIT_L(0); PG8_BAR; PG8_MMA(1, 0, At, B0); PG8_MMA(1, 1, At, B1); PG8_BAR; PG8_SCHED;
            PG8_LDB(B0, 1, 0); PG8_LDB(B1, 1, 1); PG8_SCHED; PG8_LDA(At, 1, 0); PG8_STAGE(PG8_SA(0, 1), a2 + hstep, voffA);
            PG8_WAIT_V(8); PG8_WAIT_L(0); PG8_BAR; PG8_MMA(0, 0, At, B0); PG8_MMA(0, 1, At, B1); PG8_BAR; PG8_SCHED;
            PG8_LDA(At, 1, 1); PG8_STAGE(PG8_SB(1, 0), b3, voffB); PG8_STAGE(PG8_SB(1, 1), b3 + hstep, voffB); PG8_STAGE(PG8_SA(1, 0), a3, voffA);
            PG8_WAIT_V(8); PG8_WAIT_L(0); PG8_BAR; PG8_MMA(1, 0, At, B0); PG8_MMA(1, 1, At, B1); PG8_BAR; PG8_SCHED;
            } else {
            PG8_LDB(B0, 0, 0); PG8_SCHED; PG8_LDA(At, 0, 0); PG8_STAGE(PG8_SA(1, 1), a1 + hstep, voffA);
            PG8_WAIT_L(8); PG8_BAR; PG8_WAIT_L(0); PG8_MMA(0, 0, At, B0); PG8_BAR; PG8_SCHED;
            PG8_LDB(B1, 0, 1); PG8_STAGE(PG8_SB(0, 0), b2, voffB);
            PG8_BAR; PG8_WAIT_L(0); PG8_MMA(0, 1, At, B1); PG8_BAR;
            PG8_LDA(At, 0, 1); PG8_STAGE(PG8_SA(0, 0), a2, voffA);
            PG8_BAR; PG8_WAIT_L(0); PG8_MMA(1, 0, At, B0); PG8_BAR; PG8_SCHED;
            PG8_STAGE(PG8_SB(0, 1), b2 + hstep, voffB);
            PG8_WAIT_V(6); PG8_BAR; PG8_MMA(1, 1, At, B1); PG8_BAR;
            PG8_LDB(B0, 1, 0); PG8_SCHED; PG8_LDA(At, 1, 0); PG8_STAGE(PG8_SA(0, 1), a2 + hstep, voffA);
            PG8_WAIT_L(8); PG8_BAR; PG8_WAIT_L(0); PG8_MMA(0, 0, At, B0); PG8_BAR; PG8_SCHED;
            PG8_LDB(B1, 1, 1); PG8_STAGE(PG8_SB(1, 0), b3, voffB);
            PG8_BAR; PG8_WAIT_L(0); PG8_MMA(0, 1, At, B1); PG8_BAR;
            PG8_LDA(At, 1, 1); PG8_STAGE(PG8_SA(1, 0), a3, voffA);
            PG8_BAR; PG8_WAIT_L(0); PG8_MMA(1, 0, At, B0); PG8_BAR; PG8_SCHED;
            PG8_STAGE(PG8_SB(1, 1), b3 + hstep, voffB);
            PG8_WAIT_V(6); PG8_BAR; PG8_MMA(1, 1, At, B1); PG8_BAR;
            }
        }
        if constexpr (ALIGN_EPI) { if (wr == 0) PG8_BAR; }
        if constexpr (!Epi::AFTER_DRAIN) { E(acc, cur, wr, wc, fr, fq); S.done(cur); }
        if (!has_next) break;
#pragma unroll
        for (int a = 0; a < 2; ++a)
#pragma unroll
            for (int b = 0; b < 2; ++b)
#pragma unroll
                for (int m = 0; m < 4; ++m)
#pragma unroll
                    for (int n = 0; n < 2; ++n) acc[a][b][m][n] = (f32x4){0.f, 0.f, 0.f, 0.f};
        cur = nxt; cA = nA; cB = nB; ++ui;
        if constexpr (ALIGN_EPI) { if (wr == 1) PG8_BAR; }
    }
    PG8_WAIT_V(0);
    if constexpr (!ALIGN_EPI) { if (wr == 0) PG8_BAR; }
    PG8_BAR;
    if constexpr (Epi::AFTER_DRAIN) { E.fused(acc, cur, wr, wc, fr, fq, lds, wid, lane); S.done(cur); }
#undef PG8_SA
#undef PG8_SB
#undef PG8_STAGE
#undef PG8_LDA
#undef PG8_LDB
#undef PG8_MMA
#undef PG8_WAIT_V
#undef PG8_WAIT_L
#undef PG8_BAR
#undef PG8_SCHED
}
}
constexpr int NWAVES = 8;
constexpr int NB = 2, SEQ = 4096, DM = 4096, NTOK = NB * SEQ;
constexpr int NPROJ = 6480, PROJ_LD = 6656;
constexpr int C_QA = 0, C_KA = 2048, C_VA = 2560, C_QB = 3072, C_KB = 5120, C_VB = 5248, C_QI = 5376, C_KI = 6400, C_WI = 6464;
constexpr int NADA = 6 * DM;
constexpr int NEXP = 16384, PQ_LD = 2048;
constexpr float NORM_EPS = 1e-6f;
#ifndef DBG_NOPEER
#define DBG_NOPEER 0
#endif
#ifndef DSA_TR
#define DSA_TR 0
#endif
#ifndef DBG_DSA
#define DBG_DSA 1
#endif
#ifndef MIX_ENABLE
#define MIX_ENABLE 1
#endif
constexpr size_t MiB = 1u << 20;
constexpr size_t WS_CTL = 0, CTL_ZERO_BYTES = 1 * MiB;
constexpr size_t WS_MODP = 1 * MiB;
constexpr size_t WS_COSH = 2 * MiB, WS_SINH = 4 * MiB, WS_COSI = 6 * MiB, WS_SINI = 7 * MiB;
constexpr size_t WS_SK = 8 * MiB;
constexpr size_t WS_LSE = 18 * MiB;
constexpr size_t WS_WIN = 32 * MiB;
constexpr size_t WS_WOUT = 84 * MiB;
constexpr size_t WS_WQ = 116 * MiB;
constexpr size_t WS_H = 132 * MiB;
constexpr size_t WS_PROJ = 196 * MiB;
constexpr size_t WS_SCORE = 300 * MiB;
constexpr size_t WS_OAP = 428 * MiB;
constexpr size_t WS_O = 524 * MiB;
constexpr size_t WS_X1 = 588 * MiB;
constexpr size_t WS_PQ = 716 * MiB;
constexpr size_t WS_U16 = 748 * MiB;
constexpr size_t WS_V16 = 876 * MiB;
constexpr size_t WS_END = 1004 * MiB;
constexpr int CW_BAR = 4096;
constexpr int RING_OFF = 0, RING_BYTES = 131072;
constexpr int LDSCTL_OFF = RING_BYTES, MISC_OFF = LDSCTL_OFF + 320;
constexpr int LDS_BYTES = 147456;
#define GAS __attribute__((address_space(1)))
#define LAS __attribute__((address_space(3)))
typedef unsigned short bf16;
typedef unsigned v4u __attribute__((ext_vector_type(4)));
typedef float f32x4 __attribute__((ext_vector_type(4)));
typedef short bf16x8 __attribute__((ext_vector_type(8)));
typedef GAS unsigned gu32;
typedef GAS unsigned long long gu64;
#define RLX_AGENT __ATOMIC_RELAXED, __HIP_MEMORY_SCOPE_AGENT
#define LDS_WAIT() asm volatile("s_waitcnt lgkmcnt(0)" ::: "memory")
#define VM_WAIT() asm volatile("s_waitcnt vmcnt(0)" ::: "memory")
__device__ __forceinline__ unsigned long long rt() { return __builtin_amdgcn_s_memrealtime(); }
__device__ __forceinline__ unsigned f2bf(float f) { unsigned u = __builtin_bit_cast(unsigned, f); return (u + 0x7fffu + ((u >> 16) & 1u)) >> 16; }
__device__ __forceinline__ unsigned pk2(float lo, float hi) { return f2bf(lo) | (f2bf(hi) << 16); }

#define XB_TMO      128
#define XB_XCNT(j)  (256  + 64 * (j))
#define XB_XSUB(j)  (1280 + 64 * (j))
#define XB_XGEN(j)  (2304 + 64 * (j))
#define XB_TOP      3328
#define XB_TOPGEN   3392
#define XCD_BAR_WORDS 3456
#define XB_SPIN_CAP (1u << 18)

__device__ __forceinline__ unsigned xb_ld(unsigned* p)              { return __hip_atomic_load(p, __ATOMIC_RELAXED, __HIP_MEMORY_SCOPE_AGENT); }
__device__ __forceinline__ unsigned xb_add(unsigned* p, unsigned v) { return __hip_atomic_fetch_add(p, v, __ATOMIC_RELAXED, __HIP_MEMORY_SCOPE_AGENT); }
__device__ __forceinline__ unsigned xb_xcc_id() { return (unsigned)__builtin_amdgcn_s_getreg((3 << 11) | 20) & 0xFu; }
#define XB_SPIN(cond, bar) do { unsigned _sp = 0; while (cond) { __builtin_amdgcn_s_sleep(1); \
    if ((++_sp & 255u) == 0u) { if (xb_ld(&(bar)[XB_TMO])) break; if (_sp > XB_SPIN_CAP) { atomicAdd(&(bar)[XB_TMO], 1u); break; } } } } while (0)

struct XcdBarrier {
    unsigned* bar; unsigned x;
    volatile LAS unsigned* st;
};

__device__ __forceinline__ XcdBarrier xcd_barrier_post(unsigned* bar, volatile LAS unsigned* st) {
    XcdBarrier b; b.bar = bar; b.x = xb_xcc_id(); b.st = st;
    if (threadIdx.x == 0) (void)xb_add(&bar[XB_XCNT(b.x)], 1u);
    return b;
}
__device__ __forceinline__ void xcd_barrier_complete(unsigned* bar, unsigned x, unsigned& nloc, unsigned& nx) {
    const unsigned G = gridDim.x * gridDim.y * gridDim.z;
    unsigned sum, cnt, mine, sp = 0u;
    for (;;) {
        sum = 0u; cnt = 0u; mine = 0u;
#pragma unroll
        for (unsigned j = 0; j < 16; ++j) { const unsigned c = xb_ld(&bar[XB_XCNT(j)]); sum += c; cnt += (c > 0u) ? 1u : 0u; mine = (j == x) ? c : mine; }
        if (sum == G) break;
        __builtin_amdgcn_s_sleep(1);
        if ((++sp & 255u) == 0u) { if (xb_ld(&bar[XB_TMO])) break; if (sp > XB_SPIN_CAP) { atomicAdd(&bar[XB_TMO], 1u); break; } }
    }
    nloc = mine > 0u ? mine : 1u; nx = cnt > 0u ? cnt : 1u;
}

__device__ __forceinline__ void xcd_barrier(const XcdBarrier& b) {
    asm volatile("s_waitcnt vmcnt(0)" ::: "memory");
    __syncthreads();
    if (threadIdx.x == 0) {
        unsigned* bar = b.bar;
        __builtin_amdgcn_s_waitcnt(0);
        unsigned nloc = b.st[0], nx = b.st[1];
        if (nloc == 0u) { xcd_barrier_complete(bar, b.x, nloc, nx); b.st[0] = nloc; b.st[1] = nx; }
        const unsigned old = xb_add(&bar[XB_XSUB(b.x)], 1u);
        const unsigned gen = old / nloc;
        if (old + 1u == (gen + 1u) * nloc) {
            __builtin_amdgcn_fence(__ATOMIC_RELEASE, "agent");
            asm volatile("s_waitcnt vmcnt(0)" ::: "memory");
            const unsigned og = xb_add(&bar[XB_TOP], 1u);
            const unsigned tg = og / nx;
            if (og + 1u == (tg + 1u) * nx) xb_add(&bar[XB_TOPGEN], 1u);
            else XB_SPIN(xb_ld(&bar[XB_TOPGEN]) == tg, bar);
            __builtin_amdgcn_fence(__ATOMIC_ACQUIRE, "agent");
            xb_add(&bar[XB_XGEN(b.x)], 1u);
            asm volatile("s_waitcnt vmcnt(0)" ::: "memory");
        } else {
            XB_SPIN(xb_ld(&bar[XB_XGEN(b.x)]) == gen, bar);
            __builtin_amdgcn_fence(__ATOMIC_ACQUIRE, "agent");
            asm volatile("s_waitcnt vmcnt(0)" ::: "memory");
        }
    }
    __syncthreads();
}
typedef short s16x4 __attribute__((ext_vector_type(4)));
typedef float f32x16 __attribute__((ext_vector_type(16)));
typedef float f32x2v __attribute__((ext_vector_type(2)));
typedef short v4i16_t __attribute__((ext_vector_type(4)));
#define MFMA16(a, b, c) __builtin_amdgcn_mfma_f32_16x16x32_bf16((a), (b), (c), 0, 0, 0)
#define MFMA32(a, b, c) __builtin_amdgcn_mfma_f32_32x32x16_bf16((a), (b), (c), 0, 0, 0)
#define CBAR() asm volatile("" ::: "memory")
__device__ __forceinline__ s16x4 vtr(const LAS unsigned char* p) { return __builtin_bit_cast(s16x4, __builtin_amdgcn_ds_read_tr16_b64_v4i16((LAS v4i16_t*)p)); }
__device__ __forceinline__ float bf_lo(unsigned w) { return __uint_as_float(w << 16); }
__device__ __forceinline__ float bf_hi(unsigned w) { return __uint_as_float(w & 0xffff0000u); }
__device__ __forceinline__ unsigned cvtpk(float lo, float hi) { unsigned r; asm volatile("v_cvt_pk_bf16_f32 %0, %1, %2" : "=v"(r) : "v"(lo), "v"(hi)); return r; }
__device__ __forceinline__ float wave_sum(float v) {
#pragma unroll
    for (int o = 1; o < 64; o <<= 1) v += __shfl_xor(v, o);
    return v;
}
__device__ __forceinline__ float fexp2(float x) { return __builtin_amdgcn_exp2f(x); }

struct Frame {
    LAS unsigned char* lds;
    volatile LAS unsigned* MISC;
    gu32* ctl;
    int tid, lane, wave, G;
    const float *x, *c; const int* pos; const float *ln1g, *ln2g, *w_ada, *b_ada, *w_in, *w_out, *wq, *subk, *pu, *pv, *lnfg;
    float* out;
    float *modp, *cosH, *sinH, *cosI, *sinI, *lse, *score, *x1;
    bf16 *sk, *win, *wout, *wqt, *h, *proj, *oap, *o, *pq, *u16, *v16;
};

__device__ __forceinline__ float silu_f(float v) { return v / (1.f + expf(-v)); }
__device__ __forceinline__ void p0_gemv(Frame& F) {
    LAS float* sl = (LAS float*)(F.lds);
    LAS float* red = (LAS float*)(F.lds + 32768);
    for (int i = F.tid; i < 2 * DM; i += NWAVES * 64) sl[i] = silu_f(F.c[i]);
    __syncthreads();
    for (int unit = blockIdx.x; unit < 768; unit += F.G) {
        const int cg = unit % 192, kq = unit / 192;
        const int col = cg * 128 + 2 * F.lane, k0 = kq * 1024 + F.wave * 128;
        const float* wp = F.w_ada + (size_t)k0 * NADA + col;
        float a00 = 0.f, a01 = 0.f, a10 = 0.f, a11 = 0.f;
#pragma unroll 16
        for (int k = 0; k < 128; ++k) { const f32x2v w = __builtin_nontemporal_load((const f32x2v*)(wp + (size_t)k * NADA)); const float s0 = sl[k0 + k], s1 = sl[DM + k0 + k];
            a00 += s0 * w.x; a01 += s0 * w.y; a10 += s1 * w.x; a11 += s1 * w.y; }
        red[(F.wave * 2 + 0) * 128 + 2 * F.lane] = a00; red[(F.wave * 2 + 0) * 128 + 2 * F.lane + 1] = a01;
        red[(F.wave * 2 + 1) * 128 + 2 * F.lane] = a10; red[(F.wave * 2 + 1) * 128 + 2 * F.lane + 1] = a11;
        __syncthreads();
        if (F.tid < 256) { const int b = F.tid >> 7, cc = F.tid & 127; float s = 0.f;
#pragma unroll
            for (int w = 0; w < 8; ++w) s += red[(w * 2 + b) * 128 + cc];
            F.modp[(size_t)(kq * 2 + b) * NADA + cg * 128 + cc] = s; }
        __syncthreads();
    }
}
__device__ __forceinline__ int proj_orig_col(int c) {
    if (c >= NPROJ) return -1;
    int base, w, half;
    if (c < 2560 || (c >= 3072 && c < 5248)) { base = c & ~127; w = c & 127; half = 64; }
    else if (c >= 5376 && c < 6464) { base = c & ~63; w = c & 63; half = 32; }
    else return c;
    const int i = w >> 3, j = w & 7;
    return base + ((j < 4) ? 4 * i + j : half + 4 * i + (j - 4));
}
template <bool PERMUTE>
__device__ __forceinline__ void p0_transpose_item(const float* W, int K, int N, int Nout, bf16* WT, LAS float* scr, int item, int lane) {
    const int nblk = Nout / 32, kb = item / nblk, nb = item % nblk, k0 = 64 * kb, n0 = 32 * nb;
    const int srcc = PERMUTE ? proj_orig_col(n0 + (lane & 31)) : n0 + (lane & 31);
#pragma unroll 8
    for (int i = 0; i < 32; ++i) { const int kk = 2 * i + (lane >> 5); scr[kk * 33 + (lane & 31)] = (srcc >= 0) ? W[(size_t)(k0 + kk) * N + srcc] : 0.f; }
    LDS_WAIT(); CBAR();
    const int c = lane & 7;
#pragma unroll
    for (int j = 0; j < 4; ++j) { const int n = (lane >> 3) + 8 * j; const LAS float* s = scr + (8 * c) * 33 + n;
        v4u o; o.x = pk2(s[0 * 33], s[1 * 33]); o.y = pk2(s[2 * 33], s[3 * 33]); o.z = pk2(s[4 * 33], s[5 * 33]); o.w = pk2(s[6 * 33], s[7 * 33]);
        *(GAS v4u*)(WT + (size_t)(n0 + n) * K + k0 + 8 * c) = o; }
    LDS_WAIT(); CBAR();
}
__device__ __forceinline__ void sincos_d(double a, float& sn, float& cs) {
    const double q = rint(a * 0.63661977236758134308);
    double r = fma(-q, 1.57079632679489655800, a); r = fma(-q, 6.12323399573676603587e-17, r);
    const int qi = ((int)q) & 3; const double r2 = r * r;
    double sp = -1.0 / 39916800.0; sp = fma(sp, r2, 1.0 / 362880.0); sp = fma(sp, r2, -1.0 / 5040.0); sp = fma(sp, r2, 1.0 / 120.0); sp = fma(sp, r2, -1.0 / 6.0); sp = fma(sp * r2, r, r);
    double cp = 1.0 / 479001600.0; cp = fma(cp, r2, -1.0 / 3628800.0); cp = fma(cp, r2, 1.0 / 40320.0); cp = fma(cp, r2, -1.0 / 720.0); cp = fma(cp, r2, 1.0 / 24.0); cp = fma(cp, r2, -0.5); cp = fma(cp, r2, 1.0);
    const double s = (qi & 1) ? cp : sp, c = (qi & 1) ? sp : cp;
    sn = (float)((qi & 2) ? -s : s); cs = (float)(((qi + 1) & 2) ? -c : c);
}
__device__ __forceinline__ void p0_items(Frame& F) {
    LAS float* scr = (LAS float*)(F.lds + 40960 + F.wave * 8448);
    const int gw = blockIdx.x * NWAVES + F.wave, NGW = F.G * NWAVES, lane = F.lane;
    constexpr int I_WIN = (DM / 64) * (PROJ_LD / 32), I_WOUT = (DM / 64) * (DM / 32), I_WQ = (DM / 64) * (PQ_LD / 32), I_SK = 256, I_ROPE = NTOK, I_UV = 2 * NEXP;
    constexpr int NITEMS = I_WIN + I_WOUT + I_WQ + I_SK + I_ROPE + I_UV;
    for (int it = gw; it < NITEMS; it += NGW) {
        int r = it;
        if (r < I_UV) {
            const float* src = (r < NEXP ? F.pu : F.pv) + (size_t)(r & (NEXP - 1)) * DM; bf16* dst = (r < NEXP ? F.u16 : F.v16) + (size_t)(r & (NEXP - 1)) * DM;
#pragma unroll 8
            for (int j = 0; j < 16; ++j) { const f32x4 v = __builtin_nontemporal_load((const f32x4*)(src + j * 256 + lane * 4)); unsigned long long o = (unsigned long long)pk2(v.x, v.y) | ((unsigned long long)pk2(v.z, v.w) << 32);
                *(GAS unsigned long long*)(dst + j * 256 + lane * 4) = o; }
            continue; } r -= I_UV;
        if (r < I_WIN) { p0_transpose_item<true>(F.w_in, DM, NPROJ, PROJ_LD, F.win, scr, r, lane); continue; } r -= I_WIN;
        if (r < I_WOUT) { p0_transpose_item<false>(F.w_out, DM, DM, DM, F.wout, scr, r, lane); continue; } r -= I_WOUT;
        if (r < I_WQ) { p0_transpose_item<false>(F.wq, DM, PQ_LD, PQ_LD, F.wqt, scr, r, lane); continue; } r -= I_WQ;
        if (r < I_SK) { const float* src = F.subk + (size_t)r * 1024; bf16* dst = F.sk + (size_t)r * 1024;
#pragma unroll
            for (int j = 0; j < 4; ++j) { const f32x4 v = *(const f32x4*)(src + j * 256 + lane * 4); unsigned long long o = (unsigned long long)pk2(v.x, v.y) | ((unsigned long long)pk2(v.z, v.w) << 32);
                *(GAS unsigned long long*)(dst + j * 256 + lane * 4) = o; }
            continue; } r -= I_SK;
        {
            const double p = (double)F.pos[r];
            const double LOG2_THETA = 13.287712379549449;
            { const double inv = exp2(-(double)lane * (1.0 / 64.0) * LOG2_THETA); float sn, cs; sincos_d(p * inv, sn, cs); F.cosH[(size_t)r * 64 + lane] = cs; F.sinH[(size_t)r * 64 + lane] = sn; }
            if (lane < 32) { const double inv = exp2(-(double)lane * (1.0 / 32.0) * LOG2_THETA); float sn, cs; sincos_d(p * inv, sn, cs); F.cosI[(size_t)r * 32 + lane] = cs; F.sinI[(size_t)r * 32 + lane] = sn; }
        }
    }
}
__device__ __forceinline__ void modnorm_phase(Frame& F, const float* xin, const float* g, int csh, int csc, bf16* outp) {
    LAS float* tA = (LAS float*)(F.lds);
    LAS float* tB = (LAS float*)(F.lds + 32768);
    for (int i = F.tid; i < 2 * DM; i += NWAVES * 64) { const int b = i >> 12, k = i & (DM - 1);
        float sc = F.b_ada[csc * DM + k], sh = F.b_ada[csh * DM + k];
#pragma unroll
        for (int q = 0; q < 4; ++q) { sc += F.modp[(size_t)(q * 2 + b) * NADA + csc * DM + k]; sh += F.modp[(size_t)(q * 2 + b) * NADA + csh * DM + k]; }
        tA[i] = g[k] * (1.f + sc); tB[i] = sh; }
    __syncthreads();
    const int gw = blockIdx.x * NWAVES + F.wave, NGW = F.G * NWAVES, lane = F.lane;
    for (int row = gw; row < NTOK; row += NGW) {
        const int b = row >> 12;
        const GAS f32x4* xr = (const GAS f32x4*)(xin + (size_t)row * DM) + lane;
        f32x4 v[16]; float s = 0.f;
#pragma unroll
        for (int j = 0; j < 16; ++j) { v[j] = xr[64 * j]; s += (v[j].x * v[j].x + v[j].y * v[j].y) + (v[j].z * v[j].z + v[j].w * v[j].w); }
        const float rs = 1.0f / sqrtf(wave_sum(s) * (1.f / DM) + NORM_EPS);
        GAS unsigned long long* o8 = (GAS unsigned long long*)(outp + (size_t)row * DM) + lane;
#pragma unroll
        for (int j = 0; j < 16; ++j) { const f32x4 a = *(const LAS f32x4*)(tA + b * DM + j * 256 + lane * 4), bb = *(const LAS f32x4*)(tB + b * DM + j * 256 + lane * 4);
            const f32x4 y = v[j] * rs * a + bb;
            o8[64 * j] = (unsigned long long)pk2(y.x, y.y) | ((unsigned long long)pk2(y.z, y.w) << 32); }
    }
    __syncthreads();
}
constexpr int DIL_KROWS = 224, DIL_KSTR = 272, DIL_VSTR = 288, DIL_VOFF = DIL_KROWS * DIL_KSTR;
__device__ __forceinline__ void dil_unit(Frame& F, int u) {
    const int br = u >> 9, v = u & 511, w = v & 63, bk = v >> 6, b = bk >> 2, kvh = bk & 3;
    const int dsh = 2 * br, dil = 1 << dsh, r = w & (dil - 1), qt = w >> dsh;
    const bf16* base = F.proj + (size_t)b * SEQ * PROJ_LD;
    LAS unsigned char* lds = F.lds;
    for (int c = F.tid; c < DIL_KROWS * 16; c += NWAVES * 64) { const int lr = c >> 4, ch = c & 15, jk = 64 * qt - 128 + lr;
        v4u kv = {0u, 0u, 0u, 0u}, vv = {0u, 0u, 0u, 0u};
        if (lr < 192 && jk >= 0) { const bf16* rowp = base + (size_t)(jk * dil + r) * PROJ_LD; kv = *(const GAS v4u*)(rowp + C_KA + kvh * 128 + ch * 8); vv = *(const GAS v4u*)(rowp + C_VA + kvh * 128 + ch * 8); }
        *(LAS v4u*)(lds + lr * DIL_KSTR + ch * 16) = kv; *(LAS v4u*)(lds + DIL_VOFF + lr * DIL_VSTR + ch * 16) = vv; }
    __syncthreads();
    const int lane = F.lane, wv = F.wave, n = lane & 15, rq = lane >> 4;
    bf16x8 qf[2][4];
#pragma unroll
    for (int i = 0; i < 2; ++i) { const int rho = 16 * i + n, jq = 64 * qt + 8 * wv + (rho >> 2), g = rho & 3;
        const bf16* qp = base + (size_t)(jq * dil + r) * PROJ_LD + C_QA + (kvh * 4 + g) * 128 + 8 * rq;
#pragma unroll
        for (int ks = 0; ks < 4; ++ks) qf[i][ks] = *(const GAS bf16x8*)(qp + 32 * ks); }
    f32x4 o[8][2];
#pragma unroll
    for (int dt = 0; dt < 8; ++dt) { o[dt][0] = (f32x4){0.f, 0.f, 0.f, 0.f}; o[dt][1] = (f32x4){0.f, 0.f, 0.f, 0.f}; }
    float mrun[2] = {-1e30f, -1e30f}, lrun[2] = {0.f, 0.f};
    const float SC = 0.08838834764831845f * 1.4426950408889634f;
    const float NINF = -__builtin_inff();
    const int lrmin = 128 - 64 * qt;
    for (int s = 0; s < 5; ++s) {
        const int R0 = 8 * wv + 32 * s;
        f32x4 sa[2], sb[2];
        sa[0] = sa[1] = sb[0] = sb[1] = (f32x4){0.f, 0.f, 0.f, 0.f};
#pragma unroll
        for (int ks = 0; ks < 4; ++ks) {
            const bf16x8 ka = *(const LAS bf16x8*)(lds + (R0 + n) * DIL_KSTR + (32 * ks + 8 * rq) * 2);
            const bf16x8 kb = *(const LAS bf16x8*)(lds + (R0 + 16 + n) * DIL_KSTR + (32 * ks + 8 * rq) * 2);
#pragma unroll
            for (int i = 0; i < 2; ++i) { sa[i] = MFMA16(ka, qf[i][ks], sa[i]); sb[i] = MFMA16(kb, qf[i][ks], sb[i]); }
        }
        bf16x8 pf[2];
#pragma unroll
        for (int i = 0; i < 2; ++i) {
            const int qoff = 8 * wv + 128 + ((16 * i + n) >> 2);
            const int lrA = R0 + 4 * rq;
            float pa[4], pb[4]; float mx = NINF;
#pragma unroll
            for (int e = 0; e < 4; ++e) { const int la = lrA + e, lb = lrA + 16 + e;
                const bool oka = ((unsigned)(qoff - la) <= 128u) && (la >= lrmin), okb = ((unsigned)(qoff - lb) <= 128u) && (lb >= lrmin);
                pa[e] = oka ? sa[i][e] * SC : NINF; pb[e] = okb ? sb[i][e] * SC : NINF; mx = fmaxf(mx, fmaxf(pa[e], pb[e])); }
            mx = fmaxf(mx, __shfl_xor(mx, 16)); mx = fmaxf(mx, __shfl_xor(mx, 32));
            const float mn = fmaxf(mrun[i], mx), alpha = fexp2(mrun[i] - mn); mrun[i] = mn;
            float ps = 0.f;
#pragma unroll
            for (int e = 0; e < 4; ++e) { pa[e] = fexp2(pa[e] - mn); pb[e] = fexp2(pb[e] - mn); ps += pa[e] + pb[e]; }
            ps += __shfl_xor(ps, 16); ps += __shfl_xor(ps, 32);
            lrun[i] = lrun[i] * alpha + ps;
#pragma unroll
            for (int dt = 0; dt < 8; ++dt) o[dt][i] = o[dt][i] * alpha;
            v4u pw; pw.x = cvtpk(pa[0], pa[1]); pw.y = cvtpk(pa[2], pa[3]); pw.z = cvtpk(pb[0], pb[1]); pw.w = cvtpk(pb[2], pb[3]);
            pf[i] = __builtin_bit_cast(bf16x8, pw);
        }
#pragma unroll
        for (int dt = 0; dt < 8; ++dt) {
            const LAS unsigned char* vb = lds + DIL_VOFF + (R0 + 4 * rq + (n >> 2)) * DIL_VSTR + (16 * dt + 4 * (n & 3)) * 2;
            const s16x4 t1 = vtr(vb), t2 = vtr(vb + 16 * DIL_VSTR);
            const bf16x8 vf = {t1[0], t1[1], t1[2], t1[3], t2[0], t2[1], t2[2], t2[3]};
#pragma unroll
            for (int i = 0; i < 2; ++i) o[dt][i] = MFMA16(vf, pf[i], o[dt][i]);
        }
    }
#pragma unroll
    for (int i = 0; i < 2; ++i) { const int rho = 16 * i + n, jq = 64 * qt + 8 * wv + (rho >> 2), head = kvh * 4 + (rho & 3);
        const size_t tok = (size_t)b * SEQ + jq * dil + r; const float inv = 1.f / lrun[i];
        bf16* op = F.oap + ((size_t)br * NTOK + tok) * 2048 + head * 128 + 4 * rq;
#pragma unroll
        for (int dt = 0; dt < 8; ++dt) { const f32x4 x = o[dt][i] * inv; *(GAS unsigned long long*)(op + 16 * dt) = (unsigned long long)cvtpk(x[0], x[1]) | ((unsigned long long)cvtpk(x[2], x[3]) << 32); }
        if (rq == 0) F.lse[((size_t)br * NTOK + tok) * 16 + head] = mrun[i] + log2f(lrun[i]); }
    __syncthreads();
}
__device__ __forceinline__ void idx_unit(Frame& F, int u) {
    const int b = u / 160; int id = u % 160, i, c;
    if (id < 16) { i = id; c = 0; } else if (id < 48) { id -= 16; i = 16 + id / 2; c = id % 2; } else if (id < 96) { id -= 48; i = 32 + id / 3; c = id % 3; } else { id -= 96; i = 48 + id / 4; c = id % 4; }
    const int kbeg = 1024 * c, kend = min(1024 * (c + 1), 64 * (i + 1)), ntile = (kend - kbeg) >> 5;
    const bf16* base = F.proj + (size_t)b * SEQ * PROJ_LD;
    const int lane = F.lane, rho = lane & 31, hi = lane >> 5;
    for (int rt = 0; rt < 4; ++rt) {
        const int t0 = 64 * i + 8 * F.wave + 2 * rt;
        bf16x8 af[4];
        { const bf16* qp = base + (size_t)(t0 + ((rho >> 2) & 1)) * PROJ_LD + C_QI + ((rho & 3) + 4 * (rho >> 3)) * 64 + 8 * hi;
#pragma unroll
          for (int ks = 0; ks < 4; ++ks) af[ks] = *(const GAS bf16x8*)(qp + 16 * ks); }
        float wr_[16];
        { const bf16* wp = base + (size_t)(t0 + hi) * PROJ_LD + C_WI; const v4u w0 = *(const GAS v4u*)wp, w1 = *(const GAS v4u*)(wp + 8);
          const unsigned ww[8] = {w0.x, w0.y, w0.z, w0.w, w1.x, w1.y, w1.z, w1.w};
#pragma unroll
          for (int k = 0; k < 8; ++k) { wr_[2 * k] = bf_lo(ww[k]) * 0.03125f; wr_[2 * k + 1] = bf_hi(ww[k]) * 0.03125f; } }
        float* srow = F.score + ((size_t)b * SEQ + t0 + hi) * SEQ + kbeg + rho;
        for (int kt = 0; kt < ntile; ++kt) {
            const bf16* kp = base + (size_t)(kbeg + 32 * kt + rho) * PROJ_LD + C_KI + 8 * hi;
            f32x16 acc;
#pragma unroll
            for (int k = 0; k < 16; ++k) acc[k] = 0.f;
#pragma unroll
            for (int ks = 0; ks < 4; ++ks) { const bf16x8 bfr = *(const GAS bf16x8*)(kp + 16 * ks); acc = MFMA32(af[ks], bfr, acc); }
            float sc = 0.f;
#pragma unroll
            for (int k = 0; k < 16; ++k) sc += wr_[k] * fmaxf(acc[k], 0.f);
            srow[32 * kt] = sc;
        }
    }
}
constexpr int DSA_WLDS = 1024 + 32 * DIL_VSTR;
__device__ __forceinline__ void dsa_token(Frame& F, int b, int t, LAS unsigned char* wl) {
    LAS int* sel = (LAS int*)wl; LAS unsigned char* vst = wl + 1024;
    const int lane = F.lane, n = lane & 15, rq = lane >> 4;
    const size_t tok = (size_t)b * SEQ + t; const int nvalid = t + 1;
#if !DBG_DSA
    { bf16* op = F.o + tok * DM + 2048 + lane * 32; const v4u z = {0u, 0u, 0u, 0u};
#pragma unroll
      for (int j = 0; j < 4; ++j) *(GAS v4u*)(op + 8 * j) = z; }
#else
    int nsel;
    if (nvalid <= 256) {
        nsel = nvalid;
#pragma unroll
        for (int i = 0; i < 4; ++i) { const int p = lane + 64 * i; sel[p] = p < nvalid ? p : 0; }
    } else {
        nsel = 256;
        const float* srow = F.score + tok * SEQ;
        unsigned u[64];
#pragma unroll
        for (int j = 0; j < 16; ++j) { const f32x4 v = *(const GAS f32x4*)(srow + j * 256 + lane * 4);
#pragma unroll
            for (int c = 0; c < 4; ++c) { const int idx = j * 256 + lane * 4 + c; const unsigned bits = __float_as_uint(v[c]); const unsigned key = bits ^ ((bits >> 31) ? 0xFFFFFFFFu : 0x80000000u); u[j * 4 + c] = idx <= t ? key : 0u; } }
        unsigned T = 0u;
        for (int bit = 31; bit >= 0; --bit) { const unsigned cand = T | (1u << bit); int cnt = 0;
#pragma unroll
            for (int k = 0; k < 64; ++k) cnt += __popcll(__ballot(u[k] >= cand));
            if (cnt >= 256) T = cand; }
#if DBG_DSA >= 2
        T = 0xFFFFFFFFu;
#pragma unroll
        for (int i = 0; i < 4; ++i) { const int p = lane + 64 * i; sel[p] = t - p; }
#endif
        int basep = 0;
#pragma unroll
        for (int k = 0; k < 64; ++k) { const bool gt = u[k] > T; const unsigned long long m = __ballot(gt);
            const int p = basep + (int)__builtin_amdgcn_mbcnt_hi((unsigned)(m >> 32), __builtin_amdgcn_mbcnt_lo((unsigned)m, 0u));
            if (gt) sel[p] = (k >> 2) * 256 + lane * 4 + (k & 3); basep += __popcll(m); }
#pragma unroll
        for (int k = 0; k < 64; ++k) { const bool eq = (DBG_DSA >= 2) ? false : (u[k] == T); const unsigned long long m = __ballot(eq);
            const int p = basep + (int)__builtin_amdgcn_mbcnt_hi((unsigned)(m >> 32), __builtin_amdgcn_mbcnt_lo((unsigned)m, 0u));
            if (eq && p < 256) sel[p] = (k >> 2) * 256 + lane * 4 + (k & 3); basep += __popcll(m); }
    }
    LDS_WAIT(); CBAR();
    const bf16* pb = F.proj + (size_t)b * SEQ * PROJ_LD;
    bf16x8 qf[4];
    { const bf16* qp = F.proj + tok * PROJ_LD + C_QB + n * 128 + 8 * rq;
#pragma unroll
      for (int ks = 0; ks < 4; ++ks) qf[ks] = *(const GAS bf16x8*)(qp + 32 * ks); }
    f32x4 o[8];
#pragma unroll
    for (int dt = 0; dt < 8; ++dt) o[dt] = (f32x4){0.f, 0.f, 0.f, 0.f};
    float mrun = -1e30f, lrun = 0.f;
    const float SC = 0.08838834764831845f * 1.4426950408889634f, NINF = -__builtin_inff();
    const int nsteps = (nsel + 31) >> 5;
    for (int s = 0; s < nsteps; ++s) {
        const int i0 = 32 * s;
        const int ka = sel[i0 + n], kb = sel[i0 + 16 + n];
#pragma unroll
        for (int cc = 0; cc < 8; ++cc) { const int c = cc * 64 + lane, rl = c >> 4, ch = c & 15; const int key = sel[i0 + rl];
            const v4u vv = *(const GAS v4u*)(pb + (size_t)key * PROJ_LD + C_VB + ch * 8); *(LAS v4u*)(vst + rl * DIL_VSTR + ch * 16) = vv; }
        f32x4 sa = (f32x4){0.f, 0.f, 0.f, 0.f}, sb = sa;
        { const bf16* pa_ = pb + (size_t)ka * PROJ_LD + C_KB + 8 * rq; const bf16* pb_ = pb + (size_t)kb * PROJ_LD + C_KB + 8 * rq;
#pragma unroll
          for (int ks = 0; ks < 4; ++ks) { const bf16x8 fa = *(const GAS bf16x8*)(pa_ + 32 * ks), fb = *(const GAS bf16x8*)(pb_ + 32 * ks); sa = MFMA16(fa, qf[ks], sa); sb = MFMA16(fb, qf[ks], sb); } }
        float pa[4], pbv[4]; float mx = NINF;
#pragma unroll
        for (int e = 0; e < 4; ++e) { const int pA = i0 + 4 * rq + e, pB = pA + 16;
            pa[e] = pA < nsel ? sa[e] * SC : NINF; pbv[e] = pB < nsel ? sb[e] * SC : NINF; mx = fmaxf(mx, fmaxf(pa[e], pbv[e])); }
        mx = fmaxf(mx, __shfl_xor(mx, 16)); mx = fmaxf(mx, __shfl_xor(mx, 32));
        const float mn = fmaxf(mrun, mx), alpha = fexp2(mrun - mn); mrun = mn;
        float ps = 0.f;
#pragma unroll
        for (int e = 0; e < 4; ++e) { pa[e] = fexp2(pa[e] - mn); pbv[e] = fexp2(pbv[e] - mn); ps += pa[e] + pbv[e]; }
        ps += __shfl_xor(ps, 16); ps += __shfl_xor(ps, 32);
        lrun = lrun * alpha + ps;
#pragma unroll
        for (int dt = 0; dt < 8; ++dt) o[dt] = o[dt] * alpha;
        v4u pw; pw.x = cvtpk(pa[0], pa[1]); pw.y = cvtpk(pa[2], pa[3]); pw.z = cvtpk(pbv[0], pbv[1]); pw.w = cvtpk(pbv[2], pbv[3]);
        const bf16x8 pf = __builtin_bit_cast(bf16x8, pw);
        LDS_WAIT(); CBAR();
#pragma unroll
        for (int dt = 0; dt < 8; ++dt) {
#if !DSA_TR
            bf16x8 vf;
#pragma unroll
            for (int j = 0; j < 4; ++j) { vf[j] = *(const LAS short*)(vst + (4 * rq + j) * DIL_VSTR + (16 * dt + n) * 2); vf[4 + j] = *(const LAS short*)(vst + (16 + 4 * rq + j) * DIL_VSTR + (16 * dt + n) * 2); }
#else
            const LAS unsigned char* vb = vst + (4 * rq + (n >> 2)) * DIL_VSTR + (16 * dt + 4 * (n & 3)) * 2;
            const s16x4 t1 = vtr(vb), t2 = vtr(vb + 16 * DIL_VSTR);
            const bf16x8 vf = {t1[0], t1[1], t1[2], t1[3], t2[0], t2[1], t2[2], t2[3]};
#endif
            o[dt] = MFMA16(vf, pf, o[dt]);
        }
        LDS_WAIT(); CBAR();
    }
    { const float inv = 1.f / lrun; bf16* op = F.o + tok * DM + 2048 + n * 128 + 4 * rq;
#pragma unroll
      for (int dt = 0; dt < 8; ++dt) { f32x4 x = o[dt] * inv;
#if DBG_DSA == 3
          { const float z = (mrun + log2f(lrun)) * 0.01f; x = (f32x4){z, z, z, z}; }
#endif
          *(GAS unsigned long long*)(op + 16 * dt) = (unsigned long long)cvtpk(x[0], x[1]) | ((unsigned long long)cvtpk(x[2], x[3]) << 32); } }
#endif
    { const int head = lane >> 2, d0 = (lane & 3) * 32;
      const float l0 = F.lse[((size_t)0 * NTOK + tok) * 16 + head], l1 = F.lse[((size_t)1 * NTOK + tok) * 16 + head], l2 = F.lse[((size_t)2 * NTOK + tok) * 16 + head];
      const float lm = fmaxf(l0, fmaxf(l1, l2)); float w0 = fexp2(l0 - lm), w1 = fexp2(l1 - lm), w2 = fexp2(l2 - lm); const float ws = 1.f / (w0 + w1 + w2); w0 *= ws; w1 *= ws; w2 *= ws;
      const bf16* p0 = F.oap + ((size_t)0 * NTOK + tok) * 2048 + head * 128 + d0; const bf16* p1 = F.oap + ((size_t)1 * NTOK + tok) * 2048 + head * 128 + d0; const bf16* p2 = F.oap + ((size_t)2 * NTOK + tok) * 2048 + head * 128 + d0;
      bf16* op = F.o + tok * DM + head * 128 + d0;
#pragma unroll
      for (int j = 0; j < 4; ++j) { const v4u a = *(const GAS v4u*)(p0 + 8 * j), bq = *(const GAS v4u*)(p1 + 8 * j), cq = *(const GAS v4u*)(p2 + 8 * j);
          const unsigned aa[4] = {a.x, a.y, a.z, a.w}, bb[4] = {bq.x, bq.y, bq.z, bq.w}, cc[4] = {cq.x, cq.y, cq.z, cq.w}; unsigned rr[4];
#pragma unroll
          for (int k = 0; k < 4; ++k) { const float lo = w0 * bf_lo(aa[k]) + w1 * bf_lo(bb[k]) + w2 * bf_lo(cc[k]), hi = w0 * bf_hi(aa[k]) + w1 * bf_hi(bb[k]) + w2 * bf_hi(cc[k]); rr[k] = cvtpk(lo, hi); }
          v4u ov; ov.x = rr[0]; ov.y = rr[1]; ov.z = rr[2]; ov.w = rr[3]; *(GAS v4u*)(op + 8 * j) = ov; } }
}
__device__ __forceinline__ constexpr int cand_a(int ci) { return ci < 16 ? 0 : ci < 24 ? 1 : ci < 29 ? 2 : ci < 33 ? 3 : ci < 36 ? 4 : ci < 38 ? 5 : ci < 40 ? 6 : ci < 42 ? 7 : ci - 34; }
__device__ __forceinline__ constexpr int cand_b(int ci) { return ci < 16 ? ci : ci < 24 ? ci - 16 : ci < 29 ? ci - 24 : ci < 33 ? ci - 29 : ci < 36 ? ci - 33 : ci < 38 ? ci - 36 : ci < 40 ? ci - 38 : ci < 42 ? ci - 40 : 0; }
__device__ __forceinline__ float max3f(float a, float b, float c) { return fmaxf(a, fmaxf(b, c)); }
__device__ __forceinline__ void peer_route(Frame& F, int tok0, int h, LAS int* RE, LAS float* RG) {
    const int lane = F.lane, n = lane & 15, rq = lane >> 4;
    const float NINF = -__builtin_inff();
    float top[2][16];
#pragma unroll
    for (int p = 0; p < 2; ++p) {
        f32x4 sc[8];
#pragma unroll
        for (int mt = 0; mt < 8; ++mt) sc[mt] = (f32x4){0.f, 0.f, 0.f, 0.f};
        const bf16* qp = F.pq + (size_t)(tok0 + n) * PQ_LD + h * 256 + p * 128 + 8 * rq;
        int koff = ((h * 2 + p) * 128 + n) * 128 + 8 * rq; asm volatile("" : "+v"(koff));
        const bf16* kp = F.sk + koff;
#pragma unroll
        for (int ks = 0; ks < 4; ++ks) { const bf16x8 qb = *(const GAS bf16x8*)(qp + 32 * ks);
#pragma unroll
            for (int mt = 0; mt < 8; ++mt) { const bf16x8 kf = *(const GAS bf16x8*)(kp + (size_t)mt * 16 * 128 + 32 * ks); sc[mt] = MFMA16(kf, qb, sc[mt]); }
            CBAR(); }
        float v[32];
        unsigned rq4 = 4u * (unsigned)rq; asm volatile("" : "+v"(rq4));
#pragma unroll
        for (int mt = 0; mt < 8; ++mt)
#pragma unroll
            for (int e = 0; e < 4; ++e) { const unsigned idx = 16 * mt + rq4 + e; v[mt * 4 + e] = __uint_as_float((__float_as_uint(sc[mt][e]) & ~127u) | (127u - idx)); }
#pragma unroll
        for (int rd = 0; rd < 16; ++rd) {
            float best = v[0];
#pragma unroll
            for (int k = 1; k < 32; ++k) best = fmaxf(best, v[k]);
            best = fmaxf(best, __shfl_xor(best, 16)); best = fmaxf(best, __shfl_xor(best, 32));
            top[p][rd] = best;
#pragma unroll
            for (int k = 0; k < 32; ++k) v[k] = (v[k] == best) ? NINF : v[k];
        }
    }
    int i1v[16], i2v[16];
#pragma unroll
    for (int a = 0; a < 16; ++a) { i1v[a] = 127 - (int)(__float_as_uint(top[0][a]) & 127u); i2v[a] = 127 - (int)(__float_as_uint(top[1][a]) & 127u); }
    float val[13]; int eid[13];
#pragma unroll
    for (int k = 0; k < 13; ++k) { val[k] = NINF; eid[k] = -1;
#pragma unroll
        for (int q = 0; q < 4; ++q) { const int ci = 4 * k + q;
            if (ci < 50) { const float s = top[0][cand_a(ci)] + top[1][cand_b(ci)]; const float sk = __uint_as_float((__float_as_uint(s) & ~63u) | (unsigned)(63 - ci)); const int e = i1v[cand_a(ci)] * 128 + i2v[cand_b(ci)];
                if (rq == q) { val[k] = sk; eid[k] = e; } } } }
    float ws[16]; int we[16];
#pragma unroll
    for (int rd = 0; rd < 16; ++rd) {
        float best = val[0];
#pragma unroll
        for (int k = 1; k < 13; ++k) best = fmaxf(best, val[k]);
        best = fmaxf(best, __shfl_xor(best, 16)); best = fmaxf(best, __shfl_xor(best, 32));
        int es = -1;
#pragma unroll
        for (int k = 0; k < 13; ++k) { const bool m = (val[k] == best); es = m ? eid[k] : es; val[k] = m ? NINF : val[k]; }
        es = max(es, __shfl_xor(es, 16)); es = max(es, __shfl_xor(es, 32));
        ws[rd] = best; we[rd] = es;
    }
    float ex[16]; float sum = 0.f;
#pragma unroll
    for (int k = 0; k < 16; ++k) { ex[k] = expf(ws[k] - ws[0]); sum += ex[k]; }
    const float inv = 1.f / sum;
    if (rq == 0) {
#pragma unroll
        for (int k = 0; k < 16; ++k) { RE[n * 128 + h * 16 + k] = we[k]; RG[n * 128 + h * 16 + k] = ex[k] * inv; }
    }
}
__device__ __forceinline__ float dot8(const v4u a, const v4u b, float acc) {
    const unsigned aa[4] = {a.x, a.y, a.z, a.w}, bb[4] = {b.x, b.y, b.z, b.w};
#pragma unroll
    for (int k = 0; k < 4; ++k) { acc = fmaf(bf_lo(aa[k]), bf_lo(bb[k]), acc); acc = fmaf(bf_hi(aa[k]), bf_hi(bb[k]), acc); }
    return acc;
}
__device__ __forceinline__ void peer_token(Frame& F, int tok, const LAS int* re, const LAS float* rg, LAS float* actl, const LAS float* g2, const LAS float* lnf, const float* x1) {
    const int lane = F.lane;
    v4u xr[8];
#pragma unroll
    for (int j = 0; j < 8; ++j) xr[j] = *(const GAS v4u*)(F.h + (size_t)tok * DM + j * 512 + lane * 8);
    {
        v4u cur[8];
        { const int e = __builtin_amdgcn_readfirstlane(re[0]); const bf16* up = F.u16 + (size_t)e * DM + lane * 8;
#pragma unroll
          for (int j = 0; j < 8; ++j) cur[j] = *(const GAS v4u*)(up + j * 512); }
#pragma unroll 2
        for (int k = 0; k < 128; ++k) {
            v4u nxt[8];
            { const int e = __builtin_amdgcn_readfirstlane(re[k < 127 ? k + 1 : 127]); const bf16* up = F.u16 + (size_t)e * DM + lane * 8;
#pragma unroll
              for (int j = 0; j < 8; ++j) nxt[j] = *(const GAS v4u*)(up + j * 512); }
            float acc = 0.f;
#pragma unroll
            for (int j = 0; j < 8; ++j) acc = dot8(cur[j], xr[j], acc);
            acc = wave_sum(acc);
            if (lane == 0) actl[k] = 0.5f * acc * (1.f + erff(acc * 0.70710678118654752f)) * rg[k];
#pragma unroll
            for (int j = 0; j < 8; ++j) cur[j] = nxt[j];
        }
    }
    LDS_WAIT(); CBAR();
    float outv[64];
#pragma unroll
    for (int k = 0; k < 64; ++k) outv[k] = 0.f;
    {
        v4u cur[8];
        { const int e = __builtin_amdgcn_readfirstlane(re[0]); const bf16* vp = F.v16 + (size_t)e * DM + lane * 8;
#pragma unroll
          for (int j = 0; j < 8; ++j) cur[j] = *(const GAS v4u*)(vp + j * 512); }
#pragma unroll 2
        for (int k = 0; k < 128; ++k) {
            v4u nxt[8];
            { const int e = __builtin_amdgcn_readfirstlane(re[k < 127 ? k + 1 : 127]); const bf16* vp = F.v16 + (size_t)e * DM + lane * 8;
#pragma unroll
              for (int j = 0; j < 8; ++j) nxt[j] = *(const GAS v4u*)(vp + j * 512); }
            const float act = actl[k];
#pragma unroll
            for (int j = 0; j < 8; ++j) { const unsigned w[4] = {cur[j].x, cur[j].y, cur[j].z, cur[j].w};
#pragma unroll
                for (int q = 0; q < 4; ++q) { outv[j * 8 + 2 * q] = fmaf(act, bf_lo(w[q]), outv[j * 8 + 2 * q]); outv[j * 8 + 2 * q + 1] = fmaf(act, bf_hi(w[q]), outv[j * 8 + 2 * q + 1]); } }
#pragma unroll
            for (int j = 0; j < 8; ++j) cur[j] = nxt[j];
        }
    }
    const int b = tok >> 12; float ss = 0.f;
#pragma unroll
    for (int j = 0; j < 8; ++j) {
#pragma unroll
        for (int q = 0; q < 2; ++q) { const int k = j * 512 + lane * 8 + 4 * q; const f32x4 xv = *(const GAS f32x4*)(x1 + (size_t)tok * DM + k); const f32x4 gv = *(const LAS f32x4*)(g2 + b * DM + k);
#pragma unroll
            for (int e = 0; e < 4; ++e) { const float y = xv[e] + gv[e] * outv[j * 8 + 4 * q + e]; outv[j * 8 + 4 * q + e] = y; ss += y * y; } } }
    const float rs = 1.0f / sqrtf(wave_sum(ss) * (1.f / DM) + NORM_EPS);
#pragma unroll
    for (int j = 0; j < 8; ++j) {
#pragma unroll
        for (int q = 0; q < 2; ++q) { const int k = j * 512 + lane * 8 + 4 * q; const f32x4 lv = *(const LAS f32x4*)(lnf + k); f32x4 y;
#pragma unroll
            for (int e = 0; e < 4; ++e) y[e] = outv[j * 8 + 4 * q + e] * rs * lv[e];
            *(GAS f32x4*)(F.out + (size_t)tok * DM + k) = y; } }
}
__device__ __forceinline__ void peer_phase(Frame& F, const float* x1) {
    LAS float* g2 = (LAS float*)(F.lds);
    LAS float* lnf = (LAS float*)(F.lds + 32768);
    LAS int* RE = (LAS int*)(F.lds + 49152);
    LAS float* RG = (LAS float*)(F.lds + 57344);
    LAS float* ACT = (LAS float*)(F.lds + 65536);
    for (int i = F.tid; i < 2 * DM; i += NWAVES * 64) { const int b = i >> 12, k = i & (DM - 1); float g = F.b_ada[5 * DM + k];
#pragma unroll
        for (int q = 0; q < 4; ++q) g += F.modp[(size_t)(q * 2 + b) * NADA + 5 * DM + k];
        g2[i] = DBG_NOPEER ? 0.f : g; }
    for (int i = F.tid; i < DM; i += NWAVES * 64) lnf[i] = F.lnfg[i];
    __syncthreads();
    for (int unit = blockIdx.x; unit < NTOK / 16; unit += F.G) {
        const int tok0 = unit * 16;
        peer_route(F, tok0, F.wave, RE, RG);
        __syncthreads();
#pragma unroll 1
        for (int tt = 0; tt < 2; ++tt) peer_token(F, tok0 + 2 * F.wave + tt, RE + (2 * F.wave + tt) * 128, RG + (2 * F.wave + tt) * 128, ACT + F.wave * 128, g2, lnf, x1);
        __syncthreads();
    }
}
struct Args { const void* in[14]; float* out; unsigned char* ws; int ph_lo, ph_hi; };
__global__ void __launch_bounds__(NWAVES * 64, 2) fwd_kernel(Args args) {
    extern __shared__ __attribute__((aligned(16))) unsigned char lds_raw[];
    Frame F;
    F.lds = (LAS unsigned char*)lds_raw;
    F.MISC = (volatile LAS unsigned*)(F.lds + MISC_OFF);
    F.tid = threadIdx.x; F.lane = F.tid & 63; F.wave = __builtin_amdgcn_readfirstlane(F.tid >> 6); F.G = gridDim.x;
    unsigned char* ws = args.ws;
    F.ctl = (gu32*)(ws + WS_CTL);
    F.x = (const float*)args.in[0]; F.c = (const float*)args.in[1]; F.pos = (const int*)args.in[2]; F.ln1g = (const float*)args.in[3]; F.ln2g = (const float*)args.in[4];
    F.w_ada = (const float*)args.in[5]; F.b_ada = (const float*)args.in[6]; F.w_in = (const float*)args.in[7]; F.w_out = (const float*)args.in[8]; F.wq = (const float*)args.in[9];
    F.subk = (const float*)args.in[10]; F.pu = (const float*)args.in[11]; F.pv = (const float*)args.in[12]; F.lnfg = (const float*)args.in[13]; F.out = args.out;
    F.modp = (float*)(ws + WS_MODP); F.cosH = (float*)(ws + WS_COSH); F.sinH = (float*)(ws + WS_SINH); F.cosI = (float*)(ws + WS_COSI); F.sinI = (float*)(ws + WS_SINI);
    F.lse = (float*)(ws + WS_LSE); F.score = (float*)(ws + WS_SCORE); F.x1 = (float*)(ws + WS_X1);
    F.sk = (bf16*)(ws + WS_SK); F.win = (bf16*)(ws + WS_WIN); F.wout = (bf16*)(ws + WS_WOUT); F.wqt = (bf16*)(ws + WS_WQ); F.h = (bf16*)(ws + WS_H); F.proj = (bf16*)(ws + WS_PROJ);
    F.oap = (bf16*)(ws + WS_OAP); F.o = (bf16*)(ws + WS_O); F.pq = (bf16*)(ws + WS_PQ); F.u16 = (bf16*)(ws + WS_U16); F.v16 = (bf16*)(ws + WS_V16);
    for (int u = F.tid; u < (LDS_BYTES - LDSCTL_OFF) / 4; u += NWAVES * 64) ((LAS unsigned*)(F.lds + LDSCTL_OFF))[u] = 0u;
    __syncthreads();
    XcdBarrier bar = xcd_barrier_post((unsigned*)(F.ctl + CW_BAR), F.MISC + 8);
    const int lo = args.ph_lo, hi = args.ph_hi;
#ifndef PHMASK
#define PHMASK 0x1ff
#endif
#define IN(k) (((PHMASK >> (k)) & 1) && lo <= (k) && (k) < hi)
#define SEAM(k) do { if (IN(k) && IN((k) + 1)) xcd_barrier(bar); } while (0)

    if (IN(0)) { p0_gemv(F); p0_items(F); }
    SEAM(0);
    if (IN(1)) {
#if MIX_ENABLE
        modnorm_phase(F, F.x, F.ln1g, 0, 1, F.h);
#endif
    }
    SEAM(1);
    if (IN(2)) {
#if MIX_ENABLE
        pg8::Gemm g{F.h, F.win, NTOK, PROJ_LD, DM}; pg8::StaticOrder S; S.init(NTOK, PROJ_LD, F.G, (int)blockIdx.x);
        pg8::EpiProj E{F.proj, PROJ_LD, F.cosH, F.sinH, F.cosI, F.sinI};
        pg8::gemm_phase<pg8::EpiProj, pg8::StaticOrder, true, true>(F.lds + RING_OFF, g, S, E);
#endif
    }
    SEAM(2);
    if (IN(3)) {
#if MIX_ENABLE
        for (int u = blockIdx.x; u < 320 + 1536; u += F.G) { if (u < 320) idx_unit(F, u); else dil_unit(F, u - 320); }
#endif
    }
    SEAM(3);
    if (IN(4)) {
#if MIX_ENABLE
        const int gw = blockIdx.x * NWAVES + F.wave, NGW = F.G * NWAVES;
        LAS unsigned char* wl = F.lds + F.wave * DSA_WLDS;
        for (int i = gw; i < NTOK; i += NGW) { const int b = i >> 12, r = i & (SEQ - 1); const int t = (r & 1) ? (SEQ - 1 - (r >> 1)) : (r >> 1); dsa_token(F, b, t, wl); }
        __syncthreads();
#endif
    }
    SEAM(4);
    if (IN(5)) {
#if MIX_ENABLE
        pg8::Gemm g{F.o, F.wout, NTOK, DM, DM}; pg8::StaticOrder S; S.init(NTOK, DM, F.G, (int)blockIdx.x);
        pg8::EpiRes E{F.x, F.x1, DM, F.modp, F.b_ada, 2 * DM, NADA, SEQ / 256};
        pg8::gemm_phase<pg8::EpiRes, pg8::StaticOrder, true, true>(F.lds + RING_OFF, g, S, E);
#endif
    }
    SEAM(5);
    const float* x1 = MIX_ENABLE ? F.x1 : F.x;
    if (IN(6)) modnorm_phase(F, x1, F.ln2g, 3, 4, F.h);
    SEAM(6);
    if (IN(7)) {
        pg8::Gemm g{F.h, F.wqt, NTOK, PQ_LD, DM}; pg8::StaticOrder S; S.init(NTOK, PQ_LD, F.G, (int)blockIdx.x);
        pg8::EpiStoreBf16 E{F.pq, PQ_LD};
        pg8::gemm_phase<pg8::EpiStoreBf16, pg8::StaticOrder, true, true>(F.lds + RING_OFF, g, S, E);
    }
    SEAM(7);
    if (IN(8)) peer_phase(F, x1);
#undef IN
#undef SEAM
}

#ifndef N_LAUNCHES
#define N_LAUNCHES 1
#endif
extern "C" void kernel_launch(void* const* d_in, const int* in_sizes, int n_in, void* d_out, int out_size, void* d_ws, size_t ws_size, hipStream_t stream) {
    static int grid = 0;
    if (grid == 0) {
        if (n_in != 14 || out_size != NTOK * DM || ws_size < WS_END) { fprintf(stderr, "kernel_launch: unexpected shapes (n_in %d, out %d, ws %zu)\n", n_in, out_size, ws_size); grid = -1; return; }
        int dev = 0, cus = 0, per_cu = 0;
        if (hipGetDevice(&dev) != hipSuccess || hipDeviceGetAttribute(&cus, hipDeviceAttributeMultiprocessorCount, dev) != hipSuccess) { grid = -1; return; }
        if (hipFuncSetAttribute((const void*)fwd_kernel, hipFuncAttributeMaxDynamicSharedMemorySize, LDS_BYTES) != hipSuccess) { fprintf(stderr, "kernel_launch: hipFuncSetAttribute failed\n"); grid = -1; return; }
        if (hipOccupancyMaxActiveBlocksPerMultiprocessor(&per_cu, (const void*)fwd_kernel, NWAVES * 64, LDS_BYTES) != hipSuccess || per_cu < 1) fprintf(stderr, "kernel_launch: occupancy query reports %d\n", per_cu);
        (void)hipGetLastError();
        grid = cus;
    }
    if (grid < 0) return;
    (void)hipMemsetAsync((char*)d_ws + WS_CTL, 0, CTL_ZERO_BYTES, stream);
    Args a{};
    for (int i = 0; i < 14; ++i) a.in[i] = d_in[i];
    a.out = (float*)d_out; a.ws = (unsigned char*)d_ws;
#if N_LAUNCHES == 1
    a.ph_lo = 0; a.ph_hi = 9;
    hipLaunchKernelGGL(fwd_kernel, dim3(grid), dim3(NWAVES * 64), LDS_BYTES, stream, a);
#else
    for (int p = 0; p < 9; ++p) { a.ph_lo = p; a.ph_hi = p + 1; hipLaunchKernelGGL(fwd_kernel, dim3(grid), dim3(NWAVES * 64), LDS_BYTES, stream, a); }
#endif
}
```

```cpp
#include <hip/hip_runtime.h>
#include <cstdio>
#include <cstdint>
#include <type_traits>
namespace pg8 {
#define PG8_LAS __attribute__((address_space(3)))
typedef unsigned short bf16_t;
typedef short bf16x8 __attribute__((ext_vector_type(8)));
typedef float f32x4 __attribute__((ext_vector_type(4)));
typedef unsigned u32x4 __attribute__((ext_vector_type(4)));
constexpr int BM = 256, BK = 64, HALF = 128, HTB = HALF * BK * 2  , STAGE_BYTES = 8 * HTB, NXCD = 8, WGM = 8;

__host__ __device__ __forceinline__ int lds_byte(int r, int c) { const int st = (r >> 4) * 2 + (c >> 5), rr = r & 15, cc = c & 31, ob = rr * 64 + cc * 2; return st * 1024 + (ob ^ (((ob >> 9) & 1) << 5)); }
__host__ __device__ __forceinline__ void stage_rc(int b, int& R, int& C) { const int st = b / 1024, sb = b % 1024, swz = sb ^ (((sb >> 9) & 1) << 5); R = (st >> 1) * 16 + swz / 64; C = (st & 1) * 32 + (swz % 64) / 2; }
__host__ __device__ __forceinline__ int perm32(int rho) { const int n = rho >> 4, i = rho & 15; return 8 * (i >> 2) + 4 * n + (i & 3); }

struct Unit { int pm, pn; };
struct Gemm { const bf16_t* A; const bf16_t* Bt; int M, N, K; };

struct StaticOrder {
    int nM, nN, nwg, G, c;
    __host__ __device__ void init(int M, int N, int G_, int c_) { nM = M / BM; nN = N / BM; nwg = nM * nN; G = G_; c = c_; }
    __host__ __device__ bool next(int i, Unit& u) const {
        const long L = (long)i * G + c; if (L >= nwg) return false;
        int wgid = (int)L; { const int q = nwg / NXCD, r = nwg % NXCD, xcd = wgid % NXCD, off = wgid / NXCD; wgid = (xcd < r ? xcd * (q + 1) : r * (q + 1) + (xcd - r) * q) + off; }
        const int nig = WGM * nN, gid = wgid / nig, fm = gid * WGM, gsz = (nM - fm) < WGM ? (nM - fm) : WGM;
        u.pm = fm + ((wgid % nig) % gsz); u.pn = (wgid % nig) / gsz; return true;
    }
    __device__ __forceinline__ void a_ready(const Unit&) const {}
    __device__ __forceinline__ void done(const Unit&) const {}
};

__device__ __forceinline__ unsigned cvt_pk_bf16(float lo, float hi) { unsigned r; asm volatile("v_cvt_pk_bf16_f32 %0, %1, %2" : "=v"(r) : "v"(lo), "v"(hi)); return r; }
typedef float f32x2 __attribute__((ext_vector_type(2)));
struct EpiStoreBf16 {
    static constexpr bool PERM = true, AFTER_DRAIN = false;
    bf16_t* O; int ldc;
    __device__ __forceinline__ void operator()(const f32x4 (&acc)[2][2][4][2], const Unit& u, int wr, int wc, int fr, int fq) const {
        const int row0 = u.pm * BM + wr * 64 + fr, col0 = u.pn * BM + wc * 32 + 8 * fq;
#pragma unroll
        for (int ai = 0; ai < 2; ++ai)
#pragma unroll
            for (int m = 0; m < 4; ++m) { bf16_t* rowp = O + (size_t)(row0 + ai * HALF + m * 16) * ldc + col0;
#pragma unroll
                for (int bj = 0; bj < 2; ++bj) { const f32x4 v0 = acc[ai][bj][m][0], v1 = acc[ai][bj][m][1];
                    u32x4 w; w.x = cvt_pk_bf16(v0[0], v0[1]); w.y = cvt_pk_bf16(v0[2], v0[3]); w.z = cvt_pk_bf16(v1[0], v1[1]); w.w = cvt_pk_bf16(v1[2], v1[3]);
                    *(u32x4*)(rowp + bj * HALF) = w; } }
    }
};
struct EpiProj {
    static constexpr bool PERM = true, AFTER_DRAIN = false;
    bf16_t* P; int ldc; const float* cosH; const float* sinH; const float* cosI; const float* sinI;
    __device__ __forceinline__ void operator()(const f32x4 (&acc)[2][2][4][2], const Unit& u, int wr, int wc, int fr, int fq) const {
        const int row0 = u.pm * BM + wr * 64 + fr;
#pragma unroll
        for (int bj = 0; bj < 2; ++bj) {
            const int c0 = u.pn * BM + bj * HALF + wc * 32 + 8 * fq;
            int type = 0, fo = 0;
            if (c0 < 2560 || (c0 >= 3072 && c0 < 5248)) { type = 1; fo = ((c0 & 127) >> 3) * 4; }
            else if (c0 >= 5376 && c0 < 6464) { type = 2; fo = ((c0 & 63) >> 3) * 4; }
#pragma unroll
            for (int ai = 0; ai < 2; ++ai)
#pragma unroll
                for (int m = 0; m < 4; ++m) { const int row = row0 + ai * HALF + m * 16;
                    f32x4 v0 = acc[ai][bj][m][0], v1 = acc[ai][bj][m][1];
                    if (type) { const float* ct = (type == 1) ? cosH + (size_t)row * 64 + fo : cosI + (size_t)row * 32 + fo;
                                const float* st = (type == 1) ? sinH + (size_t)row * 64 + fo : sinI + (size_t)row * 32 + fo;
                                const f32x4 cs = *(const f32x4*)ct, sn = *(const f32x4*)st;
                                const f32x4 lo = v0 * cs - v1 * sn, hi = v1 * cs + v0 * sn; v0 = lo; v1 = hi; }
                    u32x4 w; w.x = cvt_pk_bf16(v0[0], v0[1]); w.y = cvt_pk_bf16(v0[2], v0[3]); w.z = cvt_pk_bf16(v1[0], v1[1]); w.w = cvt_pk_bf16(v1[2], v1[3]);
                    *(u32x4*)(P + (size_t)row * ldc + c0) = w; }
        }
    }
};
struct EpiRes {
    static constexpr bool PERM = false, AFTER_DRAIN = false;
    const float* X; float* X1; int ldc; const float* modp; const float* bada; int chunk_off; int nada; int rows_per_batch_tile;
    __device__ __forceinline__ void operator()(const f32x4 (&acc)[2][2][4][2], const Unit& u, int wr, int wc, int fr, int fq) const {
        const int b = u.pm / rows_per_batch_tile;
        const int row0 = u.pm * BM + wr * 64 + fr;
#pragma unroll
        for (int bj = 0; bj < 2; ++bj)
#pragma unroll
            for (int n = 0; n < 2; ++n) { const int col = u.pn * BM + bj * HALF + wc * 32 + n * 16 + 4 * fq;
                f32x4 g = *(const f32x4*)(bada + chunk_off + col);
#pragma unroll
                for (int q = 0; q < 4; ++q) g += *(const f32x4*)(modp + (size_t)(q * 2 + b) * nada + chunk_off + col);
#pragma unroll
                for (int ai = 0; ai < 2; ++ai)
#pragma unroll
                    for (int m = 0; m < 4; ++m) { const size_t off = (size_t)(row0 + ai * HALF + m * 16) * ldc + col;
                        const f32x4 xv = *(const f32x4*)(X + off); *(f32x4*)(X1 + off) = xv + g * acc[ai][bj][m][n]; } }
    }
};

typedef int i32x4 __attribute__((ext_vector_type(4)));
struct EpiStoreBf16I8 {
    static constexpr bool PERM = true, AFTER_DRAIN = false;
    bf16_t* O; int ldc; const float* sa; const float* sb;
    __device__ __forceinline__ void operator()(const i32x4 (&acc)[2][2][4][2], const Unit& u, int wr, int wc, int fr, int fq) const {
        const int row0 = u.pm * BM + wr * 64 + fr, col0 = u.pn * BM + wc * 32 + 8 * fq;
        f32x4 sbv[2][2];
#pragma unroll
        for (int bj = 0; bj < 2; ++bj) { sbv[bj][0] = *(const f32x4*)(sb + col0 + bj * HALF); sbv[bj][1] = *(const f32x4*)(sb + col0 + bj * HALF + 4); }
#pragma unroll
        for (int ai = 0; ai < 2; ++ai)
#pragma unroll
            for (int m = 0; m < 4; ++m) { const int row = row0 + ai * HALF + m * 16; const float s = sa[row]; bf16_t* rowp = O + (size_t)row * ldc + col0;
#pragma unroll
                for (int bj = 0; bj < 2; ++bj) { const f32x4 v0 = __builtin_convertvector(acc[ai][bj][m][0], f32x4) * s * sbv[bj][0], v1 = __builtin_convertvector(acc[ai][bj][m][1], f32x4) * s * sbv[bj][1];
                    u32x4 w; w.x = cvt_pk_bf16(v0[0], v0[1]); w.y = cvt_pk_bf16(v0[2], v0[3]); w.z = cvt_pk_bf16(v1[0], v1[1]); w.w = cvt_pk_bf16(v1[2], v1[3]);
                    *(u32x4*)(rowp + bj * HALF) = w; } }
    }
};

struct EpiProjI8 {
    static constexpr bool PERM = true, AFTER_DRAIN = false;
    bf16_t* P; int ldc; const float* cosH; const float* sinH; const float* cosI; const float* sinI; const float* sa; const float* sb;
    __device__ __forceinline__ void operator()(const i32x4 (&acc)[2][2][4][2], const Unit& u, int wr, int wc, int fr, int fq) const {
        const int row0 = u.pm * BM + wr * 64 + fr;
#pragma unroll
        for (int bj = 0; bj < 2; ++bj) {
            const int c0 = u.pn * BM + bj * HALF + wc * 32 + 8 * fq;
            const f32x4 sb0 = *(const f32x4*)(sb + c0), sb1 = *(const f32x4*)(sb + c0 + 4);
            int type = 0, fo = 0;
            if (c0 < 2560 || (c0 >= 3072 && c0 < 5248)) { type = 1; fo = ((c0 & 127) >> 3) * 4; }
            else if (c0 >= 5376 && c0 < 6464) { type = 2; fo = ((c0 & 63) >> 3) * 4; }
#pragma unroll
            for (int ai = 0; ai < 2; ++ai)
#pragma unroll
                for (int m = 0; m < 4; ++m) { const int row = row0 + ai * HALF + m * 16; const float s = sa[row];
                    f32x4 v0 = __builtin_convertvector(acc[ai][bj][m][0], f32x4) * s * sb0, v1 = __builtin_convertvector(acc[ai][bj][m][1], f32x4) * s * sb1;
                    if (type) { const float* ct = (type == 1) ? cosH + (size_t)row * 64 + fo : cosI + (size_t)row * 32 + fo;
                                const float* st = (type == 1) ? sinH + (size_t)row * 64 + fo : sinI + (size_t)row * 32 + fo;
                                const f32x4 cs = *(const f32x4*)ct, sn = *(const f32x4*)st;
                                const f32x4 lo = v0 * cs - v1 * sn, hi = v1 * cs + v0 * sn; v0 = lo; v1 = hi; }
                    u32x4 w; w.x = cvt_pk_bf16(v0[0], v0[1]); w.y = cvt_pk_bf16(v0[2], v0[3]); w.z = cvt_pk_bf16(v1[0], v1[1]); w.w = cvt_pk_bf16(v1[2], v1[3]);
                    *(u32x4*)(P + (size_t)row * ldc + c0) = w; }
        }
    }
};

struct EpiResI8 {
    static constexpr bool PERM = true, AFTER_DRAIN = false;
    const float* X; bf16_t* X1; int ldc; const float* modp; const float* bada; int chunk_off; int nada; int rows_per_batch_tile; const float* sa; const float* sb;
    __device__ __forceinline__ void operator()(const i32x4 (&acc)[2][2][4][2], const Unit& u, int wr, int wc, int fr, int fq) const {
        const int b = u.pm / rows_per_batch_tile;
        const int row0 = u.pm * BM + wr * 64 + fr, col0 = u.pn * BM + wc * 32 + 8 * fq;
        f32x4 g[2][2];
#pragma unroll
        for (int bj = 0; bj < 2; ++bj)
#pragma unroll
            for (int n = 0; n < 2; ++n) { const int col = col0 + bj * HALF + 4 * n;
                g[bj][n] = *(const f32x4*)(modp + (size_t)b * nada + chunk_off + col) * *(const f32x4*)(sb + col); }
#pragma unroll
        for (int ai = 0; ai < 2; ++ai)
#pragma unroll
            for (int m = 0; m < 4; ++m) { const int row = row0 + ai * HALF + m * 16; const float s = sa[row];
#pragma unroll
                for (int bj = 0; bj < 2; ++bj) { const size_t off = (size_t)row * ldc + col0 + bj * HALF;
                    const f32x4 x0 = *(const f32x4*)(X + off), x1v = *(const f32x4*)(X + off + 4);
                    const f32x4 r0 = x0 + g[bj][0] * (__builtin_convertvector(acc[ai][bj][m][0], f32x4) * s), r1 = x1v + g[bj][1] * (__builtin_convertvector(acc[ai][bj][m][1], f32x4) * s);
                    u32x4 w; w.x = cvt_pk_bf16(r0[0], r0[1]); w.y = cvt_pk_bf16(r0[2], r0[3]); w.z = cvt_pk_bf16(r1[0], r1[1]); w.w = cvt_pk_bf16(r1[2], r1[3]);
                    *(u32x4*)(X1 + off) = w; } }
    }
};
template <class Epi, class Sched, bool ALIGN_EPI = false, bool SP2 = false>
__device__ __forceinline__ void gemm_phase(PG8_LAS unsigned char* lds, const Gemm g, const Sched& S, const Epi& E) {
    const int tid = threadIdx.x, wid = __builtin_amdgcn_readfirstlane(tid >> 6), lane = tid & 63, wr = wid >> 2, wc = wid & 3, fr = lane & 15, fq = lane >> 4;
    const int K = g.K, nt = K / BK;
    unsigned voffA[2], voffB[2];
#pragma unroll
    for (int i = 0; i < 2; ++i) { int R, C; stage_rc(tid * 16 + i * 8192, R, C); const int Rb = Epi::PERM ? ((R & ~31) + perm32(R & 31)) : R;
        voffA[i] = (unsigned)(R * K + C) * 2u; voffB[i] = (unsigned)(Rb * K + C) * 2u; }
    const size_t kstep = (size_t)(BK * 2);
    const size_t hstep = (size_t)HALF * K * 2;
    const size_t tstep = 2 * hstep;
    const unsigned ldsw = (unsigned)wid * 1024u;
    const int aoff = lds_byte(wr * 64 + fr, fq * 8), boff = lds_byte(wc * 32 + fr, fq * 8);
#define PG8_SA(b, h) (((b) * 2 + (h)) * HTB)
#define PG8_SB(b, h) ((4 + (b) * 2 + (h)) * HTB)
#define PG8_STAGE(bufoff, gbase, voff) do { _Pragma("unroll") for (int _i = 0; _i < 2; ++_i) \
        __builtin_amdgcn_global_load_lds((const unsigned*)((const char*)(gbase) + (voff)[_i]), (PG8_LAS unsigned*)(lds + (bufoff) + ldsw + _i * 8192), 16, 0, 0); } while (0)
#define PG8_LDA(dst, b, h) do { _Pragma("unroll") for (int m = 0; m < 4; ++m) _Pragma("unroll") for (int k = 0; k < 2; ++k) dst[m][k] = *(const PG8_LAS bf16x8*)(lds + PG8_SA(b, h) + aoff + m * 2048 + k * 1024); } while (0)
#define PG8_LDB(dst, b, h) do { _Pragma("unroll") for (int n = 0; n < 2; ++n) _Pragma("unroll") for (int k = 0; k < 2; ++k) dst[n][k] = *(const PG8_LAS bf16x8*)(lds + PG8_SB(b, h) + boff + n * 2048 + k * 1024); } while (0)
#define PG8_MMA(ai, bj, At, Bt) do { __builtin_amdgcn_s_setprio(1); _Pragma("unroll") for (int m = 0; m < 4; ++m) _Pragma("unroll") for (int n = 0; n < 2; ++n) _Pragma("unroll") for (int k = 0; k < 2; ++k) \
        acc[ai][bj][m][n] = __builtin_amdgcn_mfma_f32_16x16x32_bf16(Bt[n][k], At[m][k], acc[ai][bj][m][n], 0, 0, 0); __builtin_amdgcn_s_setprio(0); } while (0)
#define PG8_WAIT_V(n) asm volatile("s_waitcnt vmcnt(" #n ")" ::: "memory")
#define PG8_WAIT_L(n) asm volatile("s_waitcnt lgkmcnt(" #n ")" ::: "memory")
#define PG8_BAR __builtin_amdgcn_s_barrier()
#define PG8_SCHED __builtin_amdgcn_sched_barrier(0)
    Unit cur, nxt; int ui = 0;
    if (!S.next(0, cur)) return;
    f32x4 acc[2][2][4][2];
#pragma unroll
    for (int a = 0; a < 2; ++a)
#pragma unroll
        for (int b = 0; b < 2; ++b)
#pragma unroll
            for (int m = 0; m < 4; ++m)
#pragma unroll
                for (int n = 0; n < 2; ++n) acc[a][b][m][n] = (f32x4){0.f, 0.f, 0.f, 0.f};
    bf16x8 At[4][2], B0[2][2], B1[2][2];
    const char* cA = (const char*)g.A + (size_t)cur.pm * tstep; const char* cB = (const char*)g.Bt + (size_t)cur.pn * tstep;
    S.a_ready(cur);
    if constexpr (SP2) {
        PG8_STAGE(PG8_SB(0, 0), cB, voffB); PG8_STAGE(PG8_SB(0, 1), cB + hstep, voffB); PG8_STAGE(PG8_SA(0, 0), cA, voffA); PG8_STAGE(PG8_SA(0, 1), cA + hstep, voffA);
        if (wr == 1) PG8_BAR;
        PG8_WAIT_V(2); PG8_BAR;
        PG8_STAGE(PG8_SB(1, 0), cB + kstep, voffB); PG8_STAGE(PG8_SA(1, 0), cA + kstep, voffA); PG8_STAGE(PG8_SB(1, 1), cB + hstep + kstep, voffB);
        PG8_WAIT_V(6); PG8_BAR;
    } else {
        PG8_STAGE(PG8_SB(0, 0), cB, voffB); PG8_STAGE(PG8_SA(0, 0), cA, voffA); PG8_STAGE(PG8_SB(0, 1), cB + hstep, voffB); PG8_STAGE(PG8_SA(0, 1), cA + hstep, voffA);
        if (wr == 1) PG8_BAR;
        PG8_WAIT_V(4); PG8_BAR;
        PG8_STAGE(PG8_SB(1, 0), cB + kstep, voffB); PG8_STAGE(PG8_SA(1, 0), cA + kstep, voffA); PG8_STAGE(PG8_SB(1, 1), cB + hstep + kstep, voffB);
        PG8_WAIT_V(6); PG8_BAR;
    }
    for (;;) {
        const bool has_next = S.next(ui + 1, nxt);
        const char* nA = has_next ? (const char*)g.A + (size_t)nxt.pm * tstep : cA; const char* nB = has_next ? (const char*)g.Bt + (size_t)nxt.pn * tstep : cB;
        for (int t = 0; t < nt; t += 2) {
            const bool last = (t == nt - 2);
            const char* a1 = cA + (size_t)(t + 1) * kstep;
            const char* a2 = last ? nA : cA + (size_t)(t + 2) * kstep; const char* b2 = last ? nB : cB + (size_t)(t + 2) * kstep;
            const char* a3 = a2 + kstep; const char* b3 = b2 + kstep;
            if (last && has_next) S.a_ready(nxt);
            if constexpr (SP2) {
            PG8_LDB(B0, 0, 0); PG8_LDB(B1, 0, 1); PG8_SCHED; PG8_LDA(At, 0, 0); PG8_STAGE(PG8_SA(1, 1), a1 + hstep, voffA);
            PG8_WAIT_V(8); PG8_WAIT_L(0); PG8_BAR; PG8_MMA(0, 0, At, B0); PG8_MMA(0, 1, At, B1); PG8_BAR; PG8_SCHED;
            PG8_LDA(At, 0, 1); PG8_STAGE(PG8_SB(0, 0), b2, voffB); PG8_STAGE(PG8_SB(0, 1), b2 + hstep, voffB); PG8_STAGE(PG8_SA(0, 0), a2, voffA);
            PG8_WAIT_V(8); PG8_WAIT_L(0); PG8_BAR; PG8_MMA(1, 0, At, B0); PG8_MMA(1, 1, At, B1); PG8_BAR; PG8_SCHED;
            PG8_LDB(B0, 1, 0); PG8_LDB(B1, 1, 1); PG8_SCHED; PG8_LDA(At, 1, 0); PG8_STAGE(PG8_SA(0, 1), a2 + hstep, voffA);
            PG8_WAIT_V(8); PG8_WAIT_L(0); PG8_BAR; PG8_MMA(0, 0, At, B0); PG8_MMA(0, 1, At, B1); PG8_BAR; PG8_SCHED;
            PG8_LDA(At, 1, 1); PG8_STAGE(PG8_SB(1, 0), b3, voffB); PG8_STAGE(PG8_SB(1, 1), b3 + hstep, voffB); PG8_STAGE(PG8_SA(1, 0), a3, voffA);
            PG8_WAIT_V(8); PG8_WAIT_L(0); PG8_BAR; PG8_MMA(1, 0, At, B0); PG8_MMA(1, 1, At, B1); PG8_BAR; PG8_SCHED;
            } else {
            PG8_LDB(B0, 0, 0); PG8_SCHED; PG8_LDA(At, 0, 0); PG8_STAGE(PG8_SA(1, 1), a1 + hstep, voffA);
            PG8_WAIT_L(8); PG8_BAR; PG8_WAIT_L(0); PG8_MMA(0, 0, At, B0); PG8_BAR; PG8_SCHED;
            PG8_LDB(B1, 0, 1); PG8_STAGE(PG8_SB(0, 0), b2, voffB);
            PG8_BAR; PG8_WAIT_L(0); PG8_MMA(0, 1, At, B1); PG8_BAR;
            PG8_LDA(At, 0, 1); PG8_STAGE(PG8_SA(0, 0), a2, voffA);
            PG8_BAR; PG8_WAIT_L(0); PG8_MMA(1, 0, At, B0); PG8_BAR; PG8_SCHED;
            PG8_STAGE(PG8_SB(0, 1), b2 + hstep, voffB);
            PG8_WAIT_V(6); PG8_BAR; PG8_MMA(1, 1, At, B1); PG8_BAR;
            PG8_LDB(B0, 1, 0); PG8_SCHED; PG8_LDA(At, 1, 0); PG8_STAGE(PG8_SA(0, 1), a2 + hstep, voffA);
            PG8_WAIT_L(8); PG8_BAR; PG8_WAIT_L(0); PG8_MMA(0, 0, At, B0); PG8_BAR; PG8_SCHED;
            PG8_LDB(B1, 1, 1); PG8_STAGE(PG8_SB(1, 0), b3, voffB);
            PG8_BAR; PG8_WAIT_L(0); PG8_MMA(0, 1, At, B1); PG8_BAR;
            PG8_LDA(At, 1, 1); PG8_STAGE(PG8_SA(1, 0), a3, voffA);
            PG8_BAR; PG8_WAIT_L(0); PG8_MMA(1, 0, At, B0); PG8_BAR; PG8_SCHED;
            PG8_STAGE(PG8_SB(1, 1), b3 + hstep, voffB);
            PG8_WAIT_V(6); PG8_BAR; PG8_MMA(1, 1, At, B1); PG8_BAR;
            }
        }
        if constexpr (ALIGN_EPI) { if (wr == 0) PG8_BAR; }
        if constexpr (!Epi::AFTER_DRAIN) { E(acc, cur, wr, wc, fr, fq); S.done(cur); }
        if (!has_next) break;
#pragma unroll
        for (int a = 0; a < 2; ++a)
#pragma unroll
            for (int b = 0; b < 2; ++b)
#pragma unroll
                for (int m = 0; m < 4; ++m)
#pragma unroll
                    for (int n = 0; n < 2; ++n) acc[a][b][m][n] = (f32x4){0.f, 0.f, 0.f, 0.f};
        cur = nxt; cA = nA; cB = nB; ++ui;
        if constexpr (ALIGN_EPI) { if (wr == 1) PG8_BAR; }
    }
    PG8_WAIT_V(0);
    if constexpr (!ALIGN_EPI) { if (wr == 0) PG8_BAR; }
    PG8_BAR;
    if constexpr (Epi::AFTER_DRAIN) { E.fused(acc, cur, wr, wc, fr, fq, lds, wid, lane); S.done(cur); }
#undef PG8_SA
#undef PG8_SB
#undef PG8_STAGE
#undef PG8_LDA
#undef PG8_LDB
#undef PG8_MMA
#undef PG8_WAIT_V
#undef PG8_WAIT_L
#undef PG8_BAR
#undef PG8_SCHED
}

typedef int i32x4 __attribute__((ext_vector_type(4)));
template <class Epi, class Sched, bool ALIGN_EPI = false, bool SP2 = false>
__device__ __forceinline__ void gemm_phase_i8(PG8_LAS unsigned char* lds, const Gemm g, const Sched& S, const Epi& E) {
    const int tid = threadIdx.x, wid = __builtin_amdgcn_readfirstlane(tid >> 6), lane = tid & 63, wr = wid >> 2, wc = wid & 3, fr = lane & 15, fq = lane >> 4;
    const int K = g.K, nt = K / BK;
    unsigned voffA[2], voffB[2];
#pragma unroll
    for (int i = 0; i < 2; ++i) { int R, C; stage_rc(tid * 16 + i * 8192, R, C); const int Rb = Epi::PERM ? ((R & ~31) + perm32(R & 31)) : R;
        voffA[i] = (unsigned)(R * K + C) * 2u; voffB[i] = (unsigned)(Rb * K + C) * 2u; }
    const size_t kstep = (size_t)(BK * 2);
    const size_t hstep = (size_t)HALF * K * 2;
    const size_t tstep = 2 * hstep;
    const unsigned ldsw = (unsigned)wid * 1024u;
    const int aoff = lds_byte(wr * 64 + fr, fq * 8), boff = lds_byte(wc * 32 + fr, fq * 8);
#define PG8_SA(b, h) (((b) * 2 + (h)) * HTB)
#define PG8_SB(b, h) ((4 + (b) * 2 + (h)) * HTB)
#define PG8_STAGE(bufoff, gbase, voff) do { _Pragma("unroll") for (int _i = 0; _i < 2; ++_i) \
        __builtin_amdgcn_global_load_lds((const unsigned*)((const char*)(gbase) + (voff)[_i]), (PG8_LAS unsigned*)(lds + (bufoff) + ldsw + _i * 8192), 16, 0, 0); } while (0)
#define PG8_LDA(dst, b, h) do { _Pragma("unroll") for (int m = 0; m < 4; ++m) _Pragma("unroll") for (int k = 0; k < 2; ++k) dst[m][k] = *(const PG8_LAS i32x4*)(lds + PG8_SA(b, h) + aoff + m * 2048 + k * 1024); } while (0)
#define PG8_LDB(dst, b, h) do { _Pragma("unroll") for (int n = 0; n < 2; ++n) _Pragma("unroll") for (int k = 0; k < 2; ++k) dst[n][k] = *(const PG8_LAS i32x4*)(lds + PG8_SB(b, h) + boff + n * 2048 + k * 1024); } while (0)
#define PG8_MMA(ai, bj, At, Bt) do { __builtin_amdgcn_s_setprio(1); _Pragma("unroll") for (int m = 0; m < 4; ++m) _Pragma("unroll") for (int n = 0; n < 2; ++n) _Pragma("unroll") for (int k = 0; k < 2; ++k) \
        acc[ai][bj][m][n] = __builtin_amdgcn_mfma_i32_16x16x64_i8(Bt[n][k], At[m][k], acc[ai][bj][m][n], 0, 0, 0); __builtin_amdgcn_s_setprio(0); } while (0)
#define PG8_WAIT_V(n) asm volatile("s_waitcnt vmcnt(" #n ")" ::: "memory")
#define PG8_WAIT_L(n) asm volatile("s_waitcnt lgkmcnt(" #n ")" ::: "memory")
#define PG8_BAR __builtin_amdgcn_s_barrier()
#define PG8_SCHED __builtin_amdgcn_sched_barrier(0)
    Unit cur, nxt; int ui = 0;
    if (!S.next(0, cur)) return;
    i32x4 acc[2][2][4][2];
#pragma unroll
    for (int a = 0; a < 2; ++a)
#pragma unroll
        for (int b = 0; b < 2; ++b)
#pragma unroll
            for (int m = 0; m < 4; ++m)
#pragma unroll
                for (int n = 0; n < 2; ++n) acc[a][b][m][n] = (i32x4){0, 0, 0, 0};
    i32x4 At[4][2], B0[2][2], B1[2][2];
    const char* cA = (const char*)g.A + (size_t)cur.pm * tstep; const char* cB = (const char*)g.Bt + (size_t)cur.pn * tstep;
    S.a_ready(cur);
    if constexpr (SP2) {
        PG8_STAGE(PG8_SB(0, 0), cB, voffB); PG8_STAGE(PG8_SB(0, 1), cB + hstep, voffB); PG8_STAGE(PG8_SA(0, 0), cA, voffA); PG8_STAGE(PG8_SA(0, 1), cA + hstep, voffA);
        if (wr == 1) PG8_BAR;
        PG8_WAIT_V(2); PG8_BAR;
        PG8_STAGE(PG8_SB(1, 0), cB + kstep, voffB); PG8_STAGE(PG8_SA(1, 0), cA + kstep, voffA); PG8_STAGE(PG8_SB(1, 1), cB + hstep + kstep, voffB);
        PG8_WAIT_V(6); PG8_BAR;
    } else {
        PG8_STAGE(PG8_SB(0, 0), cB, voffB); PG8_STAGE(PG8_SA(0, 0), cA, voffA); PG8_STAGE(PG8_SB(0, 1), cB + hstep, voffB); PG8_STAGE(PG8_SA(0, 1), cA + hstep, voffA);
        if (wr == 1) PG8_BAR;
        PG8_WAIT_V(4); PG8_BAR;
        PG8_STAGE(PG8_SB(1, 0), cB + kstep, voffB); PG8_STAGE(PG8_SA(1, 0), cA + kstep, voffA); PG8_STAGE(PG8_SB(1, 1), cB + hstep + kstep, voffB);
        PG8_WAIT_V(6); PG8_BAR;
    }
    for (;;) {
        const bool has_next = S.next(ui + 1, nxt);
        const char* nA = has_next ? (const char*)g.A + (size_t)nxt.pm * tstep : cA; const char* nB = has_next ? (const char*)g.Bt + (size_t)nxt.pn * tstep : cB;
        for (int t = 0; t < nt; t += 2) {
            const bool last = (t == nt - 2);
            const char* a1 = cA + (size_t)(t + 1) * kstep;
            const char* a2 = last ? nA : cA + (size_t)(t + 2) * kstep; const char* b2 = last ? nB : cB + (size_t)(t + 2) * kstep;
            const char* a3 = a2 + kstep; const char* b3 = b2 + kstep;
            if (last && has_next) S.a_ready(nxt);
            if constexpr (SP2) {
            PG8_LDB(B0, 0, 0); PG8_LDB(B1, 0, 1); PG8_SCHED; PG8_LDA(At, 0, 0); PG8_STAGE(PG8_SA(1, 1), a1 + hstep, voffA);
            PG8_WAIT_V(8); PG8_WAIT_L(0); PG8_BAR; PG8_MMA(0, 0, At, B0); PG8_MMA(0, 1, At, B1); PG8_BAR; PG8_SCHED;
            PG8_LDA(At, 0, 1); PG8_STAGE(PG8_SB(0, 0), b2, voffB); PG8_STAGE(PG8_SB(0, 1), b2 + hstep, voffB); PG8_STAGE(PG8_SA(0, 0), a2, voffA);
            PG8_WAIT_V(8); PG8_WAIT_L(0); PG8_BAR; PG8_MMA(1, 0, At, B0); PG8_MMA(1, 1, At, B1); PG8_BAR; PG8_SCHED;
            PG8_LDB(B0, 1, 0); PG8_LDB(B1, 1, 1); PG8_SCHED; PG8_LDA(At, 1, 0); PG8_STAGE(PG8_SA(0, 1), a2 + hstep, voffA);
            PG8_WAIT_V(8); PG8_WAIT_L(0); PG8_BAR; PG8_MMA(0, 0, At, B0); PG8_MMA(0, 1, At, B1); PG8_BAR; PG8_SCHED;
            PG8_LDA(At, 1, 1); PG8_STAGE(PG8_SB(1, 0), b3, voffB); PG8_STAGE(PG8_SB(1, 1), b3 + hstep, voffB); PG8_STAGE(PG8_SA(1, 0), a3, voffA);
            PG8_WAIT_V(8); PG8_WAIT_L(0); PG8_BAR; PG8_MMA(1, 0, At, B0); PG8_MMA(1, 1, At, B1); PG8_BAR; PG8_SCHED;
            } else {
            PG8_LDB(B0, 0, 0); PG8_SCHED; PG8_LDA(At, 0, 0); PG8_STAGE(PG8_SA(1, 1), a1 + hstep, voffA);
            PG8_WAIT_L(8); PG8_BAR; PG8_WAIT_L(0); PG8_MMA(0, 0, At, B0); PG8_BAR; PG8_SCHED;
            PG8_LDB(B1, 0, 1); PG8_STAGE(PG8_SB(0, 0), b2, voffB);
            PG8_BAR; PG8_WAIT_L(0); PG8_MMA(0, 1, At, B1); PG8_BAR;
            PG8_LDA(At, 0, 1); PG8_STAGE(PG8_SA(0, 0), a2, voffA);
            PG8_BAR; PG8_WAIT_L(0); PG8_MMA(1, 0, At, B0); PG8_BAR; PG8_SCHED;
            PG8_STAGE(PG8_SB(0, 1), b2 + hstep, voffB);
            PG8_WAIT_V(6); PG8_BAR; PG8_MMA(1, 1, At, B1); PG8_BAR;
            PG8_LDB(B0, 1, 0); PG8_SCHED; PG8_LDA(At, 1, 0); PG8_STAGE(PG8_SA(0, 1), a2 + hstep, voffA);
            PG8_WAIT_L(8); PG8_BAR; PG8_WAIT_L(0); PG8_MMA(0, 0, At, B0); PG8_BAR; PG8_SCHED;
            PG8_LDB(B1, 1, 1); PG8_STAGE(PG8_SB(1, 0), b3, voffB);
            PG8_BAR; PG8_WAIT_L(0); PG8_MMA(0, 1, At, B1); PG8_BAR;
            PG8_LDA(At, 1, 1); PG8_STAGE(PG8_SA(1, 0), a3, voffA);
            PG8_BAR; PG8_WAIT_L(0); PG8_MMA(1, 0, At, B0); PG8_BAR; PG8_SCHED;
            PG8_STAGE(PG8_SB(1, 1), b3 + hstep, voffB);
            PG8_WAIT_V(6); PG8_BAR; PG8_MMA(1, 1, At, B1); PG8_BAR;
            }
        }
        if constexpr (ALIGN_EPI) { if (wr == 0) PG8_BAR; }
        if constexpr (!Epi::AFTER_DRAIN) { E(acc, cur, wr, wc, fr, fq); S.done(cur); }
        if (!has_next) break;
#pragma unroll
        for (int a = 0; a < 2; ++a)
#pragma unroll
            for (int b = 0; b < 2; ++b)
#pragma unroll
                for (int m = 0; m < 4; ++m)
#pragma unroll
                    for (int n = 0; n < 2; ++n) acc[a][b][m][n] = (i32x4){0, 0, 0, 0};
        cur = nxt; cA = nA; cB = nB; ++ui;
        if constexpr (ALIGN_EPI) { if (wr == 1) PG8_BAR; }
    }
    PG8_WAIT_V(0);
    if constexpr (!ALIGN_EPI) { if (wr == 0) PG8_BAR; }
    PG8_BAR;
    if constexpr (Epi::AFTER_DRAIN) { E.fused(acc, cur, wr, wc, fr, fq, lds, wid, lane); S.done(cur); }
#undef PG8_SA
#undef PG8_SB
#undef PG8_STAGE
#undef PG8_LDA
#undef PG8_LDB
#undef PG8_MMA
#undef PG8_WAIT_V
#undef PG8_WAIT_L
#undef PG8_BAR
#undef PG8_SCHED
}
}
constexpr int NWAVES = 8;
constexpr int NB = 2, SEQ = 4096, DM = 4096, NTOK = NB * SEQ;
constexpr int NPROJ = 6480, PROJ_LD = 6656;
constexpr int C_QA = 0, C_KA = 2048, C_VA = 2560, C_QB = 3072, C_KB = 5120, C_VB = 5248, C_QI = 5376, C_KI = 6400, C_WI = 6464;
constexpr int NADA = 6 * DM;
constexpr int NEXP = 16384, PQ_LD = 2048;
constexpr float NORM_EPS = 1e-6f;
#ifndef DBG_NOPEER
#define DBG_NOPEER 0
#endif
#ifndef DSA_TR
#define DSA_TR 0
#endif
#ifndef DBG_DSA
#define DBG_DSA 1
#endif
#ifndef MIX_ENABLE
#define MIX_ENABLE 1
#endif
constexpr size_t MiB = 1u << 20;
constexpr size_t WS_CTL = 0, CTL_ZERO_BYTES = 1 * MiB;
constexpr size_t WS_MODP = 1 * MiB;
constexpr size_t WS_COSH = 2 * MiB, WS_SINH = 4 * MiB, WS_COSI = 6 * MiB, WS_SINI = 7 * MiB;
constexpr size_t WS_SK = 8 * MiB;
constexpr size_t WS_USC = 20 * MiB;
constexpr size_t WS_LSE = 18 * MiB;
constexpr size_t WS_WIN = 32 * MiB;
constexpr size_t WS_WOUT = 84 * MiB;
constexpr size_t WS_WQ = 116 * MiB;
constexpr size_t WS_H = 132 * MiB;
constexpr size_t WS_PROJ = 196 * MiB;
constexpr size_t WS_SCORE = 300 * MiB;
constexpr size_t WS_OAP = 428 * MiB;
constexpr size_t WS_O = 524 * MiB;
constexpr size_t WS_X1 = 588 * MiB;
constexpr size_t WS_PQ = 716 * MiB;
constexpr int PV_ROW = 2048;
constexpr size_t WS_U16 = 748 * MiB;
constexpr size_t WS_V16 = 876 * MiB;
constexpr size_t WS_H8 = 940 * MiB;
constexpr size_t WS_WQ8 = 972 * MiB;
constexpr size_t WS_WIN8 = 980 * MiB;
constexpr size_t WS_WOUT8 = 1008 * MiB;
constexpr size_t WS_SAO = 24 * MiB, WS_SBO = 25 * MiB;
constexpr size_t WS_SBIN = 23 * MiB;
constexpr size_t WS_SAH = 21 * MiB, WS_SBQ = 22 * MiB;
constexpr size_t WS_END = 1024 * MiB;
constexpr int CW_BAR = 4096;
constexpr int RING_OFF = 0, RING_BYTES = 131072;
constexpr int LDS_BYTES = 163840;
constexpr int LDSCTL_OFF = LDS_BYTES - 1024, MISC_OFF = LDSCTL_OFF + 320;
#define GAS __attribute__((address_space(1)))
#define LAS __attribute__((address_space(3)))
typedef unsigned short bf16;
typedef unsigned v4u __attribute__((ext_vector_type(4)));
typedef float f32x4 __attribute__((ext_vector_type(4)));
typedef short bf16x8 __attribute__((ext_vector_type(8)));
typedef GAS unsigned gu32;
typedef GAS unsigned long long gu64;
#define RLX_AGENT __ATOMIC_RELAXED, __HIP_MEMORY_SCOPE_AGENT
#define LDS_WAIT() asm volatile("s_waitcnt lgkmcnt(0)" ::: "memory")
#define VM_WAIT() asm volatile("s_waitcnt vmcnt(0)" ::: "memory")
__device__ __forceinline__ unsigned long long rt() { return __builtin_amdgcn_s_memrealtime(); }
__device__ __forceinline__ unsigned f2bf(float f) { unsigned u = __builtin_bit_cast(unsigned, f); return (u + 0x7fffu + ((u >> 16) & 1u)) >> 16; }
__device__ __forceinline__ unsigned pk2(float lo, float hi) { return f2bf(lo) | (f2bf(hi) << 16); }

#define XB_TMO      128
#define XB_XCNT(j)  (256  + 64 * (j))
#define XB_XSUB(j)  (1280 + 64 * (j))
#define XB_XGEN(j)  (2304 + 64 * (j))
#define XB_TOP      3328
#define XB_TOPGEN   3392
#define XCD_BAR_WORDS 3456
#define XB_SPIN_CAP (1u << 18)

__device__ __forceinline__ unsigned xb_ld(unsigned* p)              { return __hip_atomic_load(p, __ATOMIC_RELAXED, __HIP_MEMORY_SCOPE_AGENT); }
__device__ __forceinline__ unsigned xb_add(unsigned* p, unsigned v) { return __hip_atomic_fetch_add(p, v, __ATOMIC_RELAXED, __HIP_MEMORY_SCOPE_AGENT); }
__device__ __forceinline__ unsigned xb_xcc_id() { return (unsigned)__builtin_amdgcn_s_getreg((3 << 11) | 20) & 0xFu; }
#define XB_SPIN(cond, bar) do { unsigned _sp = 0; while (cond) { __builtin_amdgcn_s_sleep(1); \
    if ((++_sp & 255u) == 0u) { if (xb_ld(&(bar)[XB_TMO])) break; if (_sp > XB_SPIN_CAP) { atomicAdd(&(bar)[XB_TMO], 1u); break; } } } } while (0)

struct XcdBarrier {
    unsigned* bar; unsigned x;
    volatile LAS unsigned* st;
};

__device__ __forceinline__ XcdBarrier xcd_barrier_post(unsigned* bar, volatile LAS unsigned* st) {
    XcdBarrier b; b.bar = bar; b.x = xb_xcc_id(); b.st = st;
    if (threadIdx.x == 0) (void)xb_add(&bar[XB_XCNT(b.x)], 1u);
    return b;
}
__device__ __forceinline__ void xcd_barrier_complete(unsigned* bar, unsigned x, unsigned& nloc, unsigned& nx) {
    const unsigned G = gridDim.x * gridDim.y * gridDim.z;
    unsigned sum, cnt, mine, sp = 0u;
    for (;;) {
        sum = 0u; cnt = 0u; mine = 0u;
#pragma unroll
        for (unsigned j = 0; j < 16; ++j) { const unsigned c = xb_ld(&bar[XB_XCNT(j)]); sum += c; cnt += (c > 0u) ? 1u : 0u; mine = (j == x) ? c : mine; }
        if (sum == G) break;
        __builtin_amdgcn_s_sleep(1);
        if ((++sp & 255u) == 0u) { if (xb_ld(&bar[XB_TMO])) break; if (sp > XB_SPIN_CAP) { atomicAdd(&bar[XB_TMO], 1u); break; } }
    }
    nloc = mine > 0u ? mine : 1u; nx = cnt > 0u ? cnt : 1u;
}

__device__ __forceinline__ void xcd_barrier(const XcdBarrier& b) {
    asm volatile("s_waitcnt vmcnt(0)" ::: "memory");
    __syncthreads();
    if (threadIdx.x == 0) {
        unsigned* bar = b.bar;
        __builtin_amdgcn_s_waitcnt(0);
        unsigned nloc = b.st[0], nx = b.st[1];
        if (nloc == 0u) { xcd_barrier_complete(bar, b.x, nloc, nx); b.st[0] = nloc; b.st[1] = nx; }
        const unsigned old = xb_add(&bar[XB_XSUB(b.x)], 1u);
        const unsigned gen = old / nloc;
        if (old + 1u == (gen + 1u) * nloc) {
            __builtin_amdgcn_fence(__ATOMIC_RELEASE, "agent");
            asm volatile("s_waitcnt vmcnt(0)" ::: "memory");
            const unsigned og = xb_add(&bar[XB_TOP], 1u);
            const unsigned tg = og / nx;
            if (og + 1u == (tg + 1u) * nx) xb_add(&bar[XB_TOPGEN], 1u);
            else XB_SPIN(xb_ld(&bar[XB_TOPGEN]) == tg, bar);
            __builtin_amdgcn_fence(__ATOMIC_ACQUIRE, "agent");
            xb_add(&bar[XB_XGEN(b.x)], 1u);
            asm volatile("s_waitcnt vmcnt(0)" ::: "memory");
        } else {
            XB_SPIN(xb_ld(&bar[XB_XGEN(b.x)]) == gen, bar);
            __builtin_amdgcn_fence(__ATOMIC_ACQUIRE, "agent");
            asm volatile("s_waitcnt vmcnt(0)" ::: "memory");
        }
    }
    __syncthreads();
}

typedef short s16x4 __attribute__((ext_vector_type(4)));
typedef float f32x16 __attribute__((ext_vector_type(16)));
typedef float f32x2v __attribute__((ext_vector_type(2)));
typedef short v4i16_t __attribute__((ext_vector_type(4)));
#define MFMA16(a, b, c) __builtin_amdgcn_mfma_f32_16x16x32_bf16((a), (b), (c), 0, 0, 0)
#define MFMA32(a, b, c) __builtin_amdgcn_mfma_f32_32x32x16_bf16((a), (b), (c), 0, 0, 0)
#define CBAR() asm volatile("" ::: "memory")
__device__ __forceinline__ s16x4 vtr(const LAS unsigned char* p) { return __builtin_bit_cast(s16x4, __builtin_amdgcn_ds_read_tr16_b64_v4i16((LAS v4i16_t*)p)); }
__device__ __forceinline__ float bf_lo(unsigned w) { return __uint_as_float(w << 16); }
__device__ __forceinline__ float bf_hi(unsigned w) { return __uint_as_float(w & 0xffff0000u); }
__device__ __forceinline__ unsigned cvtpk(float lo, float hi) { unsigned r; asm volatile("v_cvt_pk_bf16_f32 %0, %1, %2" : "=v"(r) : "v"(lo), "v"(hi)); return r; }
__device__ __forceinline__ float wave_sum(float v) {
#pragma unroll
    for (int o = 1; o < 64; o <<= 1) v += __shfl_xor(v, o);
    return v;
}
__device__ __forceinline__ float fexp2(float x) { return __builtin_amdgcn_exp2f(x); }
__device__ __forceinline__ int wave_sum_i(int v) {
    v += __builtin_amdgcn_update_dpp(0, v, 0xB1, 0xF, 0xF, true);
    v += __builtin_amdgcn_update_dpp(0, v, 0x4E, 0xF, 0xF, true);
    v += __builtin_amdgcn_update_dpp(0, v, 0x141, 0xF, 0xF, true);
    v += __builtin_amdgcn_update_dpp(0, v, 0x140, 0xF, 0xF, true);
    v += __builtin_amdgcn_update_dpp(0, v, 0x142, 0xA, 0xF, true);
    v += __builtin_amdgcn_update_dpp(0, v, 0x143, 0xC, 0xF, true);
    return __builtin_amdgcn_readlane(v, 63);
}

struct Frame {
    LAS unsigned char* lds;
    volatile LAS unsigned* MISC;
    gu32* ctl;
    int tid, lane, wave, G;
    const float *x, *c; const int* pos; const float *ln1g, *ln2g, *w_ada, *b_ada, *w_in, *w_out, *wq, *subk, *pu, *pv, *lnfg;
    float* out;
    float *modp, *cosH, *sinH, *cosI, *sinI, *lse, *score; bf16* x1;
    bf16 *sk, *win, *wout, *wqt, *h, *proj, *oap, *o, *pq; unsigned char *u8, *v8; float* usc; signed char *h8, *wq8, *win8, *o8, *wout8; float *sah, *sbq, *sbin, *sao, *sbo; int* reg; float* rgg;
};

__device__ __forceinline__ float silu_f(float v) { return v / (1.f + expf(-v)); }
__device__ __forceinline__ void p0_gemv(Frame& F) {
    LAS float* sl = (LAS float*)(F.lds);
    LAS float* red = (LAS float*)(F.lds + 32768);
    if ((int)blockIdx.x >= 192) return;
    int tid = F.tid; asm volatile("" : "+v"(tid));
    for (int i = tid; i < 2 * DM; i += NWAVES * 64) sl[i] = silu_f(F.c[i]);
    __syncthreads();
    for (int cg = blockIdx.x; cg < 192; cg += F.G) {
        const int half = F.lane >> 5, c4 = (F.lane & 31) * 4, k0 = F.wave * 512;
        const float* wp = F.w_ada + (size_t)(k0 + half) * NADA + cg * 128 + c4;
        f32x4 a0 = (f32x4){0.f, 0.f, 0.f, 0.f}, a1 = a0;
#pragma unroll 16
        for (int k = 0; k < 256; ++k) { const f32x4 w = __builtin_nontemporal_load((const f32x4*)(wp + (size_t)(2 * k) * NADA)); const float s0 = sl[k0 + 2 * k + half], s1 = sl[DM + k0 + 2 * k + half];
            a0 += w * s0; a1 += w * s1; }
#pragma unroll
        for (int e = 0; e < 4; ++e) { a0[e] += __shfl_xor(a0[e], 32); a1[e] += __shfl_xor(a1[e], 32); }
        if (half == 0) { *(LAS f32x4*)(red + (F.wave * 2 + 0) * 128 + c4) = a0; *(LAS f32x4*)(red + (F.wave * 2 + 1) * 128 + c4) = a1; }
        __syncthreads();
        if (F.tid < 256) { const int b = F.tid >> 7, cc = F.tid & 127; float s = F.b_ada[cg * 128 + cc];
#pragma unroll
            for (int w = 0; w < 8; ++w) s += red[(w * 2 + b) * 128 + cc];
            F.modp[(size_t)b * NADA + cg * 128 + cc] = s; }
        __syncthreads();
    }
}
__device__ __forceinline__ int proj_orig_col(int c) {
    if (c >= NPROJ) return -1;
    int base, w, half;
    if (c < 2560 || (c >= 3072 && c < 5248)) { base = c & ~127; w = c & 127; half = 64; }
    else if (c >= 5376 && c < 6464) { base = c & ~63; w = c & 63; half = 32; }
    else return c;
    const int i = w >> 3, j = w & 7;
    return base + ((j < 4) ? 4 * i + j : half + 4 * i + (j - 4));
}
template <bool PERMUTE>
__device__ __forceinline__ void p0_transpose_item(const float* W, int K, int N, int Nout, bf16* WT, LAS float* scr, int item, int lane) {
    const int nblk = Nout / 64, kb = item / nblk, nb = item % nblk, k0 = 64 * kb, n0 = 64 * nb;
    const int q = lane & 15, kr = lane >> 4;
    const int srcc = PERMUTE ? proj_orig_col(n0 + 4 * q) : n0 + 4 * q;
#pragma unroll 8
    for (int i = 0; i < 16; ++i) { const int kk = 4 * i + kr; f32x4 v = (f32x4){0.f, 0.f, 0.f, 0.f}; if (srcc >= 0) v = *(const f32x4*)(W + (size_t)(k0 + kk) * N + srcc);
        LAS float* d = scr + kk * 65 + 4 * q; d[0] = v.x; d[1] = v.y; d[2] = v.z; d[3] = v.w; }
    LDS_WAIT(); CBAR();
    const int c = lane & 7;
#pragma unroll
    for (int j = 0; j < 8; ++j) { const int n = (lane >> 3) + 8 * j; const LAS float* sp = scr + (8 * c) * 65 + n;
        v4u o; o.x = pk2(sp[0 * 65], sp[1 * 65]); o.y = pk2(sp[2 * 65], sp[3 * 65]); o.z = pk2(sp[4 * 65], sp[5 * 65]); o.w = pk2(sp[6 * 65], sp[7 * 65]);
        *(GAS v4u*)(WT + (size_t)(n0 + n) * K + k0 + 8 * c) = o; }
    LDS_WAIT(); CBAR();
}
__device__ __forceinline__ void sincos_d(double a, float& sn, float& cs) {
    const double q = rint(a * 0.63661977236758134308);
    double r = fma(-q, 1.57079632679489655800, a); r = fma(-q, 6.12323399573676603587e-17, r);
    const int qi = ((int)q) & 3; const double r2 = r * r;
    double sp = -1.0 / 39916800.0; sp = fma(sp, r2, 1.0 / 362880.0); sp = fma(sp, r2, -1.0 / 5040.0); sp = fma(sp, r2, 1.0 / 120.0); sp = fma(sp, r2, -1.0 / 6.0); sp = fma(sp * r2, r, r);
    double cp = 1.0 / 479001600.0; cp = fma(cp, r2, -1.0 / 3628800.0); cp = fma(cp, r2, 1.0 / 40320.0); cp = fma(cp, r2, -1.0 / 720.0); cp = fma(cp, r2, 1.0 / 24.0); cp = fma(cp, r2, -0.5); cp = fma(cp, r2, 1.0);
    const double s = (qi & 1) ? cp : sp, c = (qi & 1) ? sp : cp;
    sn = (float)((qi & 2) ? -s : s); cs = (float)(((qi + 1) & 2) ? -c : c);
}
constexpr int I_WIN = (DM / 64) * (PROJ_LD / 64), I_WOUT = (DM / 64) * (DM / 64), I_WQ = (DM / 64) * (PQ_LD / 64), I_SK = 256, I_ROPE = NTOK, I_UV = 2 * NEXP;
constexpr int NITEMS_A = I_WIN + I_SK + I_ROPE, NITEMS_B = I_UV + I_WOUT + I_WQ;
__device__ __forceinline__ void conv_item_a(Frame& F, int r, LAS float* scr) {
    const int lane = F.lane;
    if (r < I_WIN) { p0_transpose_item<true>(F.w_in, DM, NPROJ, PROJ_LD, F.win, scr, r, lane); return; } r -= I_WIN;
    if (r < I_SK) { const float* src = F.subk + (size_t)r * 1024; bf16* dst = F.sk + (size_t)r * 1024;
#pragma unroll
        for (int j = 0; j < 4; ++j) { const f32x4 v = *(const f32x4*)(src + j * 256 + lane * 4); unsigned long long o = (unsigned long long)pk2(v.x, v.y) | ((unsigned long long)pk2(v.z, v.w) << 32);
            *(GAS unsigned long long*)(dst + j * 256 + lane * 4) = o; }
        return; } r -= I_SK;
    {
        const double p = (double)F.pos[r];
        const double LOG2_THETA = 13.287712379549449;
        { const double inv = exp2(-(double)lane * (1.0 / 64.0) * LOG2_THETA); float sn, cs; sincos_d(p * inv, sn, cs); F.cosH[(size_t)r * 64 + lane] = cs; F.sinH[(size_t)r * 64 + lane] = sn; }
        if (lane < 32) { const double inv = exp2(-(double)lane * (1.0 / 32.0) * LOG2_THETA); float sn, cs; sincos_d(p * inv, sn, cs); F.cosI[(size_t)r * 32 + lane] = cs; F.sinI[(size_t)r * 32 + lane] = sn; }
    }
}
__device__ __forceinline__ void conv_item_b(Frame& F, int r, LAS float* scr) {
    const int lane = F.lane;
    if (r < NEXP) {
        const float* src = F.pu + (size_t)r * DM; unsigned char* dst = F.u8 + (size_t)r * (DM / 2);
        const int kb = 128 * (lane >> 4) + 16 * ((lane >> 2) & 3) + 4 * (lane & 3);
        f32x4 lo[8], hi[8]; float ss = 0.f;
#pragma unroll
        for (int t = 0; t < 8; ++t) { lo[t] = __builtin_nontemporal_load((const f32x4*)(src + 512 * t + kb)); hi[t] = __builtin_nontemporal_load((const f32x4*)(src + 512 * t + kb + 64));
            ss += (lo[t].x * lo[t].x + lo[t].y * lo[t].y) + (lo[t].z * lo[t].z + lo[t].w * lo[t].w) + (hi[t].x * hi[t].x + hi[t].y * hi[t].y) + (hi[t].z * hi[t].z + hi[t].w * hi[t].w); }
        ss = wave_sum(ss);
        const float step = ss > 0.f ? 0.3352f * sqrtf(ss * (1.f / DM)) : 1.f, inv = 1.f / step;
        if (lane == 0) F.usc[r] = step;
#pragma unroll
        for (int t = 0; t < 8; ++t) { const float fl[4] = {lo[t].x, lo[t].y, lo[t].z, lo[t].w}, fh[4] = {hi[t].x, hi[t].y, hi[t].z, hi[t].w}; unsigned w = 0u;
#pragma unroll
            for (int i = 0; i < 4; ++i) { int ql = (int)floorf(fl[i] * inv) + 8, qh = (int)floorf(fh[i] * inv) + 8; ql = ql < 0 ? 0 : (ql > 15 ? 15 : ql); qh = qh < 0 ? 0 : (qh > 15 ? 15 : qh);
                w |= ((unsigned)ql | ((unsigned)qh << 4)) << (8 * i); }
            *(GAS unsigned*)(dst + 256 * t + 4 * lane) = w; }
        return; } r -= NEXP;
    if (r < NEXP) {
        unsigned char* dst = F.v8 + (size_t)r * PV_ROW;
        f32x4 v[2][8]; float ss = 0.f;
#pragma unroll
        for (int j = 0; j < 2; ++j) { const float* src = F.pv + (size_t)r * DM + j * 2048 + 4 * lane;
#pragma unroll
            for (int i = 0; i < 8; ++i) { v[j][i] = __builtin_nontemporal_load((const f32x4*)(src + 256 * i)); ss += (v[j][i].x * v[j][i].x + v[j][i].y * v[j][i].y) + (v[j][i].z * v[j][i].z + v[j][i].w * v[j][i].w); } }
        ss = wave_sum(ss);
        const float scl = ss > 0.f ? (2.6f / 6.f) * sqrtf(ss * (1.f / DM)) : 1.f, iv = 1.f / scl;
        if (lane == 0) F.usc[NEXP + r] = scl;
#pragma unroll
        for (int j = 0; j < 2; ++j) { unsigned wq[4];
#pragma unroll
            for (int d = 0; d < 4; ++d) { const f32x4 a = v[j][2 * d] * iv, c = v[j][2 * d + 1] * iv; unsigned w = 0u;
                w = __builtin_amdgcn_cvt_scalef32_pk_fp4_f32(w, a.x, a.y, 1.0f, 0); w = __builtin_amdgcn_cvt_scalef32_pk_fp4_f32(w, a.z, a.w, 1.0f, 1);
                w = __builtin_amdgcn_cvt_scalef32_pk_fp4_f32(w, c.x, c.y, 1.0f, 2); w = __builtin_amdgcn_cvt_scalef32_pk_fp4_f32(w, c.z, c.w, 1.0f, 3);
                wq[d] = w; }
            *(GAS v4u*)(dst + j * 1024 + lane * 16) = (v4u){wq[0], wq[1], wq[2], wq[3]}; }
        return; } r -= NEXP;
    if (r < I_WOUT) { p0_transpose_item<false>(F.w_out, DM, DM, DM, F.wout, scr, r, lane); return; } r -= I_WOUT;
    p0_transpose_item<false>(F.wq, DM, PQ_LD, PQ_LD, F.wqt, scr, r, lane);
}
__device__ __forceinline__ void p0_items(Frame& F) {
    LAS float* scr = (LAS float*)(F.lds + F.wave * 16640);
    gu32* ctr = F.ctl + 80;
    for (;;) {
        __syncthreads();
        if (F.tid == 0) F.MISC[12] = __hip_atomic_fetch_add(ctr, 1u, __ATOMIC_RELAXED, __HIP_MEMORY_SCOPE_AGENT);
        __syncthreads();
        const int it = (int)F.MISC[12] * NWAVES + F.wave;
        if (it - F.wave >= NITEMS_A) break;
        if (it < NITEMS_A) conv_item_a(F, it, scr);
    }
}
__device__ __forceinline__ unsigned pack_i8x4(float a, float b, float c, float d) {
    const int q0 = (int)rintf(a), q1 = (int)rintf(b), q2 = (int)rintf(c), q3 = (int)rintf(d);
    return (unsigned)(q0 & 255) | ((unsigned)(q1 & 255) << 8) | ((unsigned)(q2 & 255) << 16) | ((unsigned)q3 << 24);
}
__device__ __forceinline__ void quant_row_bf16_i8(const bf16* src, signed char* dst, float* sc_slot, int lane) {
    v4u xr[8]; float am = 0.f;
#pragma unroll
    for (int j = 0; j < 8; ++j) { xr[j] = *(const GAS v4u*)(src + j * 512 + lane * 8); const unsigned w[4] = {xr[j].x, xr[j].y, xr[j].z, xr[j].w};
#pragma unroll
        for (int q = 0; q < 4; ++q) am = fmaxf(am, fmaxf(fabsf(bf_lo(w[q])), fabsf(bf_hi(w[q])))); }
#pragma unroll
    for (int o = 1; o < 64; o <<= 1) am = fmaxf(am, __shfl_xor(am, o));
    const float s = am > 0.f ? 127.f / am : 1.f;
    if (lane == 0) *sc_slot = am > 0.f ? am * (1.f / 127.f) : 1.f;
#pragma unroll
    for (int j = 0; j < 8; ++j) { const unsigned w[4] = {xr[j].x, xr[j].y, xr[j].z, xr[j].w};
        const unsigned lo = pack_i8x4(bf_lo(w[0]) * s, bf_hi(w[0]) * s, bf_lo(w[1]) * s, bf_hi(w[1]) * s), hi = pack_i8x4(bf_lo(w[2]) * s, bf_hi(w[2]) * s, bf_lo(w[3]) * s, bf_hi(w[3]) * s);
        *(GAS unsigned long long*)(dst + j * 512 + lane * 8) = (unsigned long long)lo | ((unsigned long long)hi << 32); }
}
template <typename XT>
__device__ __forceinline__ void modnorm_phase(Frame& F, const XT* xin, const float* g, int csh, int csc, bf16* outp, signed char* out8 = nullptr, float* sa8 = nullptr) {
    constexpr bool XB = sizeof(XT) == 2;
    LAS float* tA = (LAS float*)(F.lds);
    LAS float* tB = (LAS float*)(F.lds + 32768);
    int tid = F.tid; asm volatile("" : "+v"(tid));
    for (int i = tid; i < 2 * DM; i += NWAVES * 64) { const int b = i >> 12, k = i & (DM - 1);
        const float sc = F.modp[(size_t)b * NADA + csc * DM + k], sh = F.modp[(size_t)b * NADA + csh * DM + k];
        tA[i] = g[k] * (1.f + sc); tB[i] = sh; }
    __syncthreads();
    const int gw = blockIdx.x * NWAVES + F.wave, NGW = F.G * NWAVES, lane = F.lane;
    typedef typename std::conditional<XB, unsigned long long, f32x4>::type RawT;
    f32x4 v[16];
    if (gw < NTOK) { const GAS RawT* xr = (const GAS RawT*)(xin + (size_t)gw * DM) + lane;
#pragma unroll
        for (int j = 0; j < 16; ++j) { const RawT w = xr[64 * j];
            if constexpr (XB) { const unsigned lo = (unsigned)w, hi = (unsigned)(w >> 32); v[j] = (f32x4){bf_lo(lo), bf_hi(lo), bf_lo(hi), bf_hi(hi)}; } else v[j] = w; } }
    for (int row = gw; row < NTOK; row += NGW) {
        const int b = row >> 12;
        RawT nv[16];
        { const int rn = row + NGW < NTOK ? row + NGW : row; const GAS RawT* xr = (const GAS RawT*)(xin + (size_t)rn * DM) + lane;
#pragma unroll
          for (int j = 0; j < 16; ++j) nv[j] = xr[64 * j]; }
        CBAR();
        float s = 0.f;
#pragma unroll
        for (int j = 0; j < 16; ++j) s += (v[j].x * v[j].x + v[j].y * v[j].y) + (v[j].z * v[j].z + v[j].w * v[j].w);
        const float rs = 1.0f / sqrtf(wave_sum(s) * (1.f / DM) + NORM_EPS);
        GAS unsigned long long* o8 = (GAS unsigned long long*)(outp + (size_t)row * DM) + lane;
        float am = 0.f;
#pragma unroll
        for (int j = 0; j < 16; ++j) { const f32x4 a = *(const LAS f32x4*)(tA + b * DM + j * 256 + lane * 4), bb = *(const LAS f32x4*)(tB + b * DM + j * 256 + lane * 4);
            const f32x4 y = v[j] * rs * a + bb; v[j] = y;
            am = fmaxf(am, fmaxf(fmaxf(fabsf(y.x), fabsf(y.y)), fmaxf(fabsf(y.z), fabsf(y.w))));
            if (outp) o8[64 * j] = (unsigned long long)pk2(y.x, y.y) | ((unsigned long long)pk2(y.z, y.w) << 32);
            if ((j & 3) == 3) CBAR(); }
        if (out8) {
#pragma unroll
            for (int o = 1; o < 64; o <<= 1) am = fmaxf(am, __shfl_xor(am, o));
            const float s8 = am > 0.f ? 127.f / am : 1.f;
            if (lane == 0) sa8[row] = am > 0.f ? am * (1.f / 127.f) : 1.f;
            GAS unsigned* q8 = (GAS unsigned*)(out8 + (size_t)row * DM) + lane;
#pragma unroll
            for (int j = 0; j < 16; ++j) q8[64 * j] = pack_i8x4(v[j].x * s8, v[j].y * s8, v[j].z * s8, v[j].w * s8); }
#pragma unroll
        for (int j = 0; j < 16; ++j) { if constexpr (XB) { const unsigned lo = (unsigned)nv[j], hi = (unsigned)(nv[j] >> 32); v[j] = (f32x4){bf_lo(lo), bf_hi(lo), bf_lo(hi), bf_hi(hi)}; } else v[j] = nv[j]; }
    }
    __syncthreads();
}
constexpr int DIL_KROWS = 224, DIL_KSTR = 272, DIL_VSTR = 288, DIL_VOFF = DIL_KROWS * DIL_KSTR;
struct DilUnit { int br, b, kvh, dil, r, qt; };
__device__ __forceinline__ DilUnit dil_decode(int u) { DilUnit d; d.br = u >> 9; const int v = u & 511, w = v & 63, bk = v >> 6; d.b = bk >> 2; d.kvh = bk & 3; const int dsh = 2 * d.br; d.dil = 1 << dsh; d.r = w & (d.dil - 1); d.qt = w >> dsh; return d; }
__device__ __forceinline__ void dil_load_rows(Frame& F, const DilUnit& d, v4u (&rk)[7], v4u (&rv)[7]) {
    const bf16* base = F.proj + (size_t)d.b * SEQ * PROJ_LD;
#pragma unroll
    for (int i = 0; i < 7; ++i) { const int c = F.tid + 512 * i, lr = c >> 4, ch = c & 15, jk = 64 * d.qt - 128 + lr;
        rk[i] = (v4u){0u, 0u, 0u, 0u}; rv[i] = (v4u){0u, 0u, 0u, 0u};
        if (lr < 192 && jk >= 0) { const bf16* rowp = base + (size_t)(jk * d.dil + d.r) * PROJ_LD; rk[i] = *(const GAS v4u*)(rowp + C_KA + d.kvh * 128 + ch * 8); rv[i] = *(const GAS v4u*)(rowp + C_VA + d.kvh * 128 + ch * 8); } }
}
__device__ __forceinline__ void dil_store_rows(Frame& F, const v4u (&rk)[7], const v4u (&rv)[7]) {
#pragma unroll
    for (int i = 0; i < 7; ++i) { const int c = F.tid + 512 * i, lr = c >> 4, ch = c & 15;
        *(LAS v4u*)(F.lds + lr * DIL_KSTR + ch * 16) = rk[i]; *(LAS v4u*)(F.lds + DIL_VOFF + lr * DIL_VSTR + ch * 16) = rv[i]; }
}
__device__ __forceinline__ void dil_load_q(Frame& F, const DilUnit& d, bf16x8 (&qf)[2][4]) {
    const bf16* base = F.proj + (size_t)d.b * SEQ * PROJ_LD;
    const int lane = F.lane, wv = F.wave, n = lane & 15, rq = lane >> 4;
#pragma unroll
    for (int i = 0; i < 2; ++i) { const int rho = 16 * i + n, jq = 64 * d.qt + 8 * wv + (rho >> 2), g = rho & 3;
        const bf16* qp = base + (size_t)(jq * d.dil + d.r) * PROJ_LD + C_QA + (d.kvh * 4 + g) * 128 + 8 * rq;
#pragma unroll
        for (int ks = 0; ks < 4; ++ks) qf[i][ks] = *(const GAS bf16x8*)(qp + 32 * ks); }
}
__device__ __forceinline__ void dil_compute(Frame& F, const DilUnit& d, const bf16x8 (&qf)[2][4]) {
    const int br = d.br, b = d.b, kvh = d.kvh, dil = d.dil, r = d.r, qt = d.qt;
    LAS unsigned char* lds = F.lds;
    const int lane = F.lane, wv = F.wave, n = lane & 15, rq = lane >> 4;
    f32x4 o[8][2];
#pragma unroll
    for (int dt = 0; dt < 8; ++dt) { o[dt][0] = (f32x4){0.f, 0.f, 0.f, 0.f}; o[dt][1] = (f32x4){0.f, 0.f, 0.f, 0.f}; }
    float mrun[2] = {-1e30f, -1e30f}, lrun[2] = {0.f, 0.f};
    const float SC = 0.08838834764831845f * 1.4426950408889634f;
    const float NINF = -__builtin_inff();
    const int lrmin = 128 - 64 * qt;
    for (int s = 0; s < 5; ++s) {
        const int R0 = 8 * wv + 32 * s;
        f32x4 sa[2], sb[2];
        sa[0] = sa[1] = sb[0] = sb[1] = (f32x4){0.f, 0.f, 0.f, 0.f};
#pragma unroll
        for (int ks = 0; ks < 4; ++ks) {
            const bf16x8 ka = *(const LAS bf16x8*)(lds + (R0 + n) * DIL_KSTR + (32 * ks + 8 * rq) * 2);
            const bf16x8 kb = *(const LAS bf16x8*)(lds + (R0 + 16 + n) * DIL_KSTR + (32 * ks + 8 * rq) * 2);
#pragma unroll
            for (int i = 0; i < 2; ++i) { sa[i] = MFMA16(ka, qf[i][ks], sa[i]); sb[i] = MFMA16(kb, qf[i][ks], sb[i]); }
        }
        bf16x8 pf[2];
#pragma unroll
        for (int i = 0; i < 2; ++i) {
            const int qoff = 8 * wv + 128 + ((16 * i + n) >> 2);
            const int lrA = R0 + 4 * rq;
            float pa[4], pb[4]; float mx = NINF;
#pragma unroll
            for (int e = 0; e < 4; ++e) { const int la = lrA + e, lb = lrA + 16 + e;
                const bool oka = ((unsigned)(qoff - la) <= 128u) && (la >= lrmin), okb = ((unsigned)(qoff - lb) <= 128u) && (lb >= lrmin);
                pa[e] = oka ? sa[i][e] * SC : NINF; pb[e] = okb ? sb[i][e] * SC : NINF; mx = fmaxf(mx, fmaxf(pa[e], pb[e])); }
            mx = fmaxf(mx, __shfl_xor(mx, 16)); mx = fmaxf(mx, __shfl_xor(mx, 32));
            const float mn = fmaxf(mrun[i], mx), alpha = fexp2(mrun[i] - mn); mrun[i] = mn;
            float ps = 0.f;
#pragma unroll
            for (int e = 0; e < 4; ++e) { pa[e] = fexp2(pa[e] - mn); pb[e] = fexp2(pb[e] - mn); ps += pa[e] + pb[e]; }
            ps += __shfl_xor(ps, 16); ps += __shfl_xor(ps, 32);
            lrun[i] = lrun[i] * alpha + ps;
#pragma unroll
            for (int dt = 0; dt < 8; ++dt) o[dt][i] = o[dt][i] * alpha;
            v4u pw; pw.x = cvtpk(pa[0], pa[1]); pw.y = cvtpk(pa[2], pa[3]); pw.z = cvtpk(pb[0], pb[1]); pw.w = cvtpk(pb[2], pb[3]);
            pf[i] = __builtin_bit_cast(bf16x8, pw);
        }
#pragma unroll
        for (int dt = 0; dt < 8; ++dt) {
            const LAS unsigned char* vb = lds + DIL_VOFF + (R0 + 4 * rq + (n >> 2)) * DIL_VSTR + (16 * dt + 4 * (n & 3)) * 2;
            const s16x4 t1 = vtr(vb), t2 = vtr(vb + 16 * DIL_VSTR);
            const bf16x8 vf = {t1[0], t1[1], t1[2], t1[3], t2[0], t2[1], t2[2], t2[3]};
#pragma unroll
            for (int i = 0; i < 2; ++i) o[dt][i] = MFMA16(vf, pf[i], o[dt][i]);
        }
    }
#pragma unroll
    for (int i = 0; i < 2; ++i) { const int rho = 16 * i + n, jq = 64 * qt + 8 * wv + (rho >> 2), head = kvh * 4 + (rho & 3);
        const size_t tok = (size_t)b * SEQ + jq * dil + r; const float inv = 1.f / lrun[i];
        bf16* op = F.oap + ((size_t)br * NTOK + tok) * 2048 + head * 128 + 4 * rq;
#pragma unroll
        for (int dt = 0; dt < 8; ++dt) { const f32x4 x = o[dt][i] * inv; *(GAS unsigned long long*)(op + 16 * dt) = (unsigned long long)cvtpk(x[0], x[1]) | ((unsigned long long)cvtpk(x[2], x[3]) << 32); }
        if (rq == 0) F.lse[((size_t)br * NTOK + tok) * 16 + head] = mrun[i] + log2f(lrun[i]); }
}
__device__ __forceinline__ int p3_next(Frame& F, gu32* ctr) {
    __syncthreads();
    if (F.tid == 0) F.MISC[12] = __hip_atomic_fetch_add(ctr, 1u, __ATOMIC_RELAXED, __HIP_MEMORY_SCOPE_AGENT);
    __syncthreads();
    return (int)F.MISC[12];
}
__device__ __forceinline__ void dil_units(Frame& F, int u0, gu32* ctr, int nunits) {
    if (u0 >= nunits) return;
    v4u rk[7], rv[7]; bf16x8 qf[2][4];
    DilUnit d = dil_decode(u0);
    dil_load_rows(F, d, rk, rv); dil_load_q(F, d, qf);
    if (F.tid == 0) F.MISC[12] = __hip_atomic_fetch_add(ctr, 1u, __ATOMIC_RELAXED, __HIP_MEMORY_SCOPE_AGENT);
    for (;;) {
        __syncthreads();
        dil_store_rows(F, rk, rv);
        const int un = (int)F.MISC[12] - 320; const bool has_next = un < nunits;
        __syncthreads();
        unsigned nn = 0u;
        if (has_next && F.tid == 0) nn = __hip_atomic_fetch_add(ctr, 1u, __ATOMIC_RELAXED, __HIP_MEMORY_SCOPE_AGENT);
        DilUnit dn = d;
        if (has_next) { dn = dil_decode(un); dil_load_rows(F, dn, rk, rv); }
        CBAR();
        dil_compute(F, d, qf);
        if (!has_next) break;
        if (F.tid == 0) F.MISC[12] = nn;
        d = dn;
        dil_load_q(F, d, qf);
    }
    __syncthreads();
}
__device__ __forceinline__ float relu_f(float x) { return __builtin_amdgcn_fmed3f(x, 0.f, 3.0e38f); }
__device__ __forceinline__ void idx_unit(Frame& F, int u) {
    const int b = u / 160; int id = u % 160, i, c;
    if (id < 16) { i = id; c = 0; } else if (id < 48) { id -= 16; i = 16 + id / 2; c = id % 2; } else if (id < 96) { id -= 48; i = 32 + id / 3; c = id % 3; } else { id -= 96; i = 48 + id / 4; c = id % 4; }
    const int kbeg = 1024 * c, kend = min(1024 * (c + 1), 64 * (i + 1)), ntile = (kend - kbeg) >> 5;
    const bf16* base = F.proj + (size_t)b * SEQ * PROJ_LD;
    const int lane = F.lane, rho = lane & 31, hi = lane >> 5;
    const int t0 = 64 * i + 8 * F.wave;
    bf16x8 af[4][4]; v4u wq[4][2];
#pragma unroll
    for (int rt = 0; rt < 4; ++rt) {
        const bf16* qp = base + (size_t)(t0 + 2 * rt + ((rho >> 2) & 1)) * PROJ_LD + C_QI + ((rho & 3) + 4 * (rho >> 3)) * 64 + 8 * hi;
#pragma unroll
        for (int ks = 0; ks < 4; ++ks) af[rt][ks] = *(const GAS bf16x8*)(qp + 16 * ks);
        const bf16* wp = base + (size_t)(t0 + 2 * rt + hi) * PROJ_LD + C_WI; wq[rt][0] = *(const GAS v4u*)wp; wq[rt][1] = *(const GAS v4u*)(wp + 8);
    }
    float* srow = F.score + ((size_t)b * SEQ + t0 + hi) * SEQ + kbeg + rho;
    const bf16* kp = base + (size_t)(kbeg + rho) * PROJ_LD + C_KI + 8 * hi;
    bf16x8 bc[4];
#pragma unroll
    for (int ks = 0; ks < 4; ++ks) bc[ks] = *(const GAS bf16x8*)(kp + 16 * ks);
    for (int kt = 0; kt < ntile; ++kt) {
        bf16x8 bn[4];
        { const bf16* kn = kp + (size_t)(kt + 1 < ntile ? kt + 1 : kt) * 32 * PROJ_LD;
#pragma unroll
          for (int ks = 0; ks < 4; ++ks) bn[ks] = *(const GAS bf16x8*)(kn + 16 * ks); }
        f32x16 acc[4];
#pragma unroll
        for (int rt = 0; rt < 4; ++rt)
#pragma unroll
            for (int k = 0; k < 16; ++k) acc[rt][k] = 0.f;
#pragma unroll
        for (int ks = 0; ks < 4; ++ks)
#pragma unroll
            for (int rt = 0; rt < 4; ++rt) acc[rt] = MFMA32(af[rt][ks], bc[ks], acc[rt]);
#pragma unroll
        for (int rt = 0; rt < 4; ++rt) { float sc = 0.f; const unsigned ww[8] = {wq[rt][0].x, wq[rt][0].y, wq[rt][0].z, wq[rt][0].w, wq[rt][1].x, wq[rt][1].y, wq[rt][1].z, wq[rt][1].w};
#pragma unroll
            for (int k = 0; k < 8; ++k) { sc = fmaf(bf_lo(ww[k]), relu_f(acc[rt][2 * k]), sc); sc = fmaf(bf_hi(ww[k]), relu_f(acc[rt][2 * k + 1]), sc); }
            srow[(size_t)2 * rt * SEQ + 32 * kt] = sc * 0.03125f; }
#pragma unroll
        for (int ks = 0; ks < 4; ++ks) bc[ks] = bn[ks];
    }
}
constexpr int DSA_WLDS = 1024 + 32 * DIL_VSTR;
__device__ __forceinline__ unsigned pk_satsub_u16(unsigned a, unsigned b) { unsigned d; asm("v_pk_sub_u16 %0, %1, %2 clamp" : "=v"(d) : "v"(a), "v"(b)); return d; }
__device__ __forceinline__ unsigned pk_min_u16(unsigned a, unsigned b) { unsigned d; asm("v_pk_min_u16 %0, %1, %2" : "=v"(d) : "v"(a), "v"(b)); return d; }
__device__ __forceinline__ unsigned pk_add_u16(unsigned a, unsigned b) { unsigned d; asm("v_pk_add_u16 %0, %1, %2" : "=v"(d) : "v"(a), "v"(b)); return d; }
__device__ __forceinline__ unsigned pk_sub_u16(unsigned a, unsigned b) { unsigned d; asm("v_pk_sub_u16 %0, %1, %2" : "=v"(d) : "v"(a), "v"(b)); return d; }
__device__ __forceinline__ void dsa_token(Frame& F, int b_, int t_, LAS unsigned char* wl) {
    const int b = __builtin_amdgcn_readfirstlane(b_), t = __builtin_amdgcn_readfirstlane(t_);
    LAS int* sel = (LAS int*)wl; LAS unsigned char* vst = wl + 1024;
    const int lane = F.lane, n = lane & 15, rq = lane >> 4;
    const size_t tok = (size_t)b * SEQ + t; const int nvalid = t + 1;
    int nsel;
    if (nvalid <= 256) {
        nsel = nvalid;
#pragma unroll
        for (int i = 0; i < 4; ++i) { const int p = lane + 64 * i; sel[p] = p < nvalid ? p : 0; }
    } else {
        nsel = 256;
        const float* srow = F.score + tok * SEQ;
        unsigned u[64];
#pragma unroll
        for (int j = 0; j < 16; ++j) { f32x4 v = (f32x4){0.f, 0.f, 0.f, 0.f}; if (j <= (t >> 8)) v = *(const GAS f32x4*)(srow + j * 256 + lane * 4);
#pragma unroll
            for (int c = 0; c < 4; ++c) { const int idx = j * 256 + lane * 4 + c; const unsigned bits = __float_as_uint(v[c]); const unsigned key = bits ^ ((bits >> 31) ? 0xFFFFFFFFu : 0x80000000u); u[j * 4 + c] = idx <= t ? key : 0u; } }
        const int jmax = t >> 8;
        unsigned T; bool exact = false;
        { unsigned H[32];
#pragma unroll
          for (int i = 0; i < 32; ++i) H[i] = __builtin_amdgcn_perm(u[2 * i + 1], u[2 * i], 0x07060302u);
          unsigned TH = 0u;
          for (int bit = 15; bit >= 0; --bit) { const unsigned c16 = TH | (1u << bit), cm1 = (c16 - 1u) * 0x10001u; unsigned acc = 0u;
#pragma unroll
              for (int j = 0; j < 16; ++j) if (j <= jmax) {
#pragma unroll
                  for (int q = 0; q < 2; ++q) acc = pk_add_u16(acc, pk_min_u16(pk_satsub_u16(H[2 * j + q], cm1), 0x00010001u)); }
              const int tot = wave_sum_i((int)((acc & 0xFFFFu) + (acc >> 16)));
              if (tot >= 256) { TH = c16; if (tot == 256) { exact = true; break; } } }
          T = TH << 16;
          if (!exact) {
              int ngt = 0;
              if (TH != 0xFFFFu) { const unsigned cm1 = TH * 0x10001u; unsigned acc = 0u;
#pragma unroll
                  for (int j = 0; j < 16; ++j) if (j <= jmax) {
#pragma unroll
                      for (int q = 0; q < 2; ++q) acc = pk_add_u16(acc, pk_min_u16(pk_satsub_u16(H[2 * j + q], cm1), 0x00010001u)); }
                  ngt = wave_sum_i((int)((acc & 0xFFFFu) + (acc >> 16))); }
              const int need = 256 - ngt;
              const unsigned THp = TH * 0x10001u;
#pragma unroll
              for (int i = 0; i < 32; ++i) { const unsigned ne = pk_min_u16(H[i] ^ THp, 0x00010001u);
                  H[i] = __builtin_amdgcn_perm(u[2 * i + 1], u[2 * i], 0x05040100u) & pk_sub_u16(ne, 0x00010001u); }
              unsigned TL = 0u;
              for (int bit = 15; bit >= 0; --bit) { const unsigned c16 = TL | (1u << bit), cm1 = (c16 - 1u) * 0x10001u; unsigned acc = 0u;
#pragma unroll
                  for (int j = 0; j < 16; ++j) if (j <= jmax) {
#pragma unroll
                      for (int q = 0; q < 2; ++q) acc = pk_add_u16(acc, pk_min_u16(pk_satsub_u16(H[2 * j + q], cm1), 0x00010001u)); }
                  const int tot = wave_sum_i((int)((acc & 0xFFFFu) + (acc >> 16)));
                  if (tot >= need) { TL = c16; if (tot == need) { exact = true; break; } } }
              T |= TL; } }
        int basep = 0;
#pragma unroll
        for (int k = 0; k < 64; ++k) if ((k >> 2) <= jmax) { const bool gt = exact ? (u[k] >= T) : (u[k] > T); const unsigned long long m = __ballot(gt);
            const int p = basep + (int)__builtin_amdgcn_mbcnt_hi((unsigned)(m >> 32), __builtin_amdgcn_mbcnt_lo((unsigned)m, 0u));
            if (gt) sel[p] = (k >> 2) * 256 + lane * 4 + (k & 3); basep += __popcll(m); }
        if (!exact)
#pragma unroll
        for (int k = 0; k < 64; ++k) if ((k >> 2) <= jmax) { const bool eq = u[k] == T; const unsigned long long m = __ballot(eq);
            const int p = basep + (int)__builtin_amdgcn_mbcnt_hi((unsigned)(m >> 32), __builtin_amdgcn_mbcnt_lo((unsigned)m, 0u));
            if (eq && p < 256) sel[p] = (k >> 2) * 256 + lane * 4 + (k & 3); basep += __popcll(m); }
    }
    LDS_WAIT(); CBAR();
    const bf16* pb = F.proj + (size_t)b * SEQ * PROJ_LD;
    bf16x8 qf[4];
    { const bf16* qp = F.proj + tok * PROJ_LD + C_QB + n * 128 + 8 * rq;
#pragma unroll
      for (int ks = 0; ks < 4; ++ks) qf[ks] = *(const GAS bf16x8*)(qp + 32 * ks); }
    f32x4 o[8];
#pragma unroll
    for (int dt = 0; dt < 8; ++dt) o[dt] = (f32x4){0.f, 0.f, 0.f, 0.f};
    float mrun = -1e30f, lrun = 0.f;
    const float SC = 0.08838834764831845f * 1.4426950408889634f, NINF = -__builtin_inff();
    const int nsteps = (nsel + 31) >> 5;
    bf16x8 kf[8]; v4u vr[8];
    { const int ka = sel[n], kb = sel[16 + n]; int vk[8];
#pragma unroll
      for (int cc = 0; cc < 8; ++cc) vk[cc] = sel[cc * 4 + rq];
      const bf16* pa_ = pb + (size_t)ka * PROJ_LD + C_KB + 8 * rq; const bf16* pb_ = pb + (size_t)kb * PROJ_LD + C_KB + 8 * rq;
#pragma unroll
      for (int ks = 0; ks < 4; ++ks) { kf[ks] = *(const GAS bf16x8*)(pa_ + 32 * ks); kf[4 + ks] = *(const GAS bf16x8*)(pb_ + 32 * ks); }
#pragma unroll
      for (int cc = 0; cc < 8; ++cc) vr[cc] = *(const GAS v4u*)(pb + (size_t)vk[cc] * PROJ_LD + C_VB + n * 8); }
    for (int s = 0; s < nsteps; ++s) {
        const int i0 = 32 * s;
#pragma unroll
        for (int cc = 0; cc < 8; ++cc) *(LAS v4u*)(vst + (cc * 4 + rq) * DIL_VSTR + n * 16) = vr[cc];
        bf16x8 kn[8];
        { const int i1 = (s + 1 < nsteps) ? i0 + 32 : i0;
          const int ka = sel[i1 + n], kb = sel[i1 + 16 + n]; int vk[8];
#pragma unroll
          for (int cc = 0; cc < 8; ++cc) vk[cc] = sel[i1 + cc * 4 + rq];
          const bf16* pa_ = pb + (size_t)ka * PROJ_LD + C_KB + 8 * rq; const bf16* pb_ = pb + (size_t)kb * PROJ_LD + C_KB + 8 * rq;
#pragma unroll
          for (int ks = 0; ks < 4; ++ks) { kn[ks] = *(const GAS bf16x8*)(pa_ + 32 * ks); kn[4 + ks] = *(const GAS bf16x8*)(pb_ + 32 * ks); }
#pragma unroll
          for (int cc = 0; cc < 8; ++cc) vr[cc] = *(const GAS v4u*)(pb + (size_t)vk[cc] * PROJ_LD + C_VB + n * 8); }
        f32x4 sa = (f32x4){0.f, 0.f, 0.f, 0.f}, sb = sa;
#pragma unroll
        for (int ks = 0; ks < 4; ++ks) { sa = MFMA16(kf[ks], qf[ks], sa); sb = MFMA16(kf[4 + ks], qf[ks], sb); }
        float pa[4], pbv[4]; float mx = NINF;
#pragma unroll
        for (int e = 0; e < 4; ++e) { const int pA = i0 + 4 * rq + e, pB = pA + 16;
            pa[e] = pA < nsel ? sa[e] * SC : NINF; pbv[e] = pB < nsel ? sb[e] * SC : NINF; mx = fmaxf(mx, fmaxf(pa[e], pbv[e])); }
        mx = fmaxf(mx, __shfl_xor(mx, 16)); mx = fmaxf(mx, __shfl_xor(mx, 32));
        const float mn = fmaxf(mrun, mx), alpha = fexp2(mrun - mn); mrun = mn;
        float ps = 0.f;
#pragma unroll
        for (int e = 0; e < 4; ++e) { pa[e] = fexp2(pa[e] - mn); pbv[e] = fexp2(pbv[e] - mn); ps += pa[e] + pbv[e]; }
        ps += __shfl_xor(ps, 16); ps += __shfl_xor(ps, 32);
        lrun = lrun * alpha + ps;
#pragma unroll
        for (int dt = 0; dt < 8; ++dt) o[dt] = o[dt] * alpha;
        v4u pw; pw.x = cvtpk(pa[0], pa[1]); pw.y = cvtpk(pa[2], pa[3]); pw.z = cvtpk(pbv[0], pbv[1]); pw.w = cvtpk(pbv[2], pbv[3]);
        const bf16x8 pf = __builtin_bit_cast(bf16x8, pw);
        LDS_WAIT(); CBAR();
#pragma unroll
        for (int dt = 0; dt < 8; ++dt) {
#if !DSA_TR
            bf16x8 vf;
#pragma unroll
            for (int j = 0; j < 4; ++j) { vf[j] = *(const LAS short*)(vst + (4 * rq + j) * DIL_VSTR + (16 * dt + n) * 2); vf[4 + j] = *(const LAS short*)(vst + (16 + 4 * rq + j) * DIL_VSTR + (16 * dt + n) * 2); }
#else
            const LAS unsigned char* vb = vst + (4 * rq + (n >> 2)) * DIL_VSTR + (16 * dt + 4 * (n & 3)) * 2;
            const s16x4 t1 = vtr(vb), t2 = vtr(vb + 16 * DIL_VSTR);
            const bf16x8 vf = {t1[0], t1[1], t1[2], t1[3], t2[0], t2[1], t2[2], t2[3]};
#endif
            o[dt] = MFMA16(vf, pf, o[dt]);
        }
        LDS_WAIT(); CBAR();
#pragma unroll
        for (int k = 0; k < 8; ++k) kf[k] = kn[k];
    }
    { const float inv = 1.f / lrun; float am = 0.f;
#pragma unroll
      for (int dt = 0; dt < 8; ++dt) { o[dt] = o[dt] * inv; am = fmaxf(am, fmaxf(fmaxf(fabsf(o[dt][0]), fabsf(o[dt][1])), fmaxf(fabsf(o[dt][2]), fabsf(o[dt][3])))); }
      const int head = lane >> 2, d0 = (lane & 3) * 32;
      const float l0 = F.lse[((size_t)0 * NTOK + tok) * 16 + head], l1 = F.lse[((size_t)1 * NTOK + tok) * 16 + head], l2 = F.lse[((size_t)2 * NTOK + tok) * 16 + head];
      const float lm = fmaxf(l0, fmaxf(l1, l2)); float w0 = fexp2(l0 - lm), w1 = fexp2(l1 - lm), w2 = fexp2(l2 - lm); const float ws = 1.f / (w0 + w1 + w2); w0 *= ws; w1 *= ws; w2 *= ws;
      const bf16* p0 = F.oap + ((size_t)0 * NTOK + tok) * 2048 + head * 128 + d0; const bf16* p1 = F.oap + ((size_t)1 * NTOK + tok) * 2048 + head * 128 + d0; const bf16* p2 = F.oap + ((size_t)2 * NTOK + tok) * 2048 + head * 128 + d0;
      float oa[32];
#pragma unroll
      for (int j = 0; j < 4; ++j) { const v4u a = *(const GAS v4u*)(p0 + 8 * j), bq = *(const GAS v4u*)(p1 + 8 * j), cq = *(const GAS v4u*)(p2 + 8 * j);
          const unsigned aa[4] = {a.x, a.y, a.z, a.w}, bb[4] = {bq.x, bq.y, bq.z, bq.w}, cc[4] = {cq.x, cq.y, cq.z, cq.w};
#pragma unroll
          for (int k = 0; k < 4; ++k) { const float lo = w0 * bf_lo(aa[k]) + w1 * bf_lo(bb[k]) + w2 * bf_lo(cc[k]), hi = w0 * bf_hi(aa[k]) + w1 * bf_hi(bb[k]) + w2 * bf_hi(cc[k]);
              oa[8 * j + 2 * k] = lo; oa[8 * j + 2 * k + 1] = hi; am = fmaxf(am, fmaxf(fabsf(lo), fabsf(hi))); } }
#pragma unroll
      for (int of = 1; of < 64; of <<= 1) am = fmaxf(am, __shfl_xor(am, of));
      const float s8 = am > 0.f ? 127.f / am : 1.f;
      if (lane == 0) F.sao[tok] = am > 0.f ? am * (1.f / 127.f) : 1.f;
      signed char* orow = F.o8 + tok * DM;
#pragma unroll
      for (int dt = 0; dt < 8; ++dt) *(GAS unsigned*)(orow + 2048 + n * 128 + 16 * dt + 4 * rq) = pack_i8x4(o[dt][0] * s8, o[dt][1] * s8, o[dt][2] * s8, o[dt][3] * s8);
#pragma unroll
      for (int j = 0; j < 4; ++j) { const unsigned lo = pack_i8x4(oa[8 * j] * s8, oa[8 * j + 1] * s8, oa[8 * j + 2] * s8, oa[8 * j + 3] * s8), hi = pack_i8x4(oa[8 * j + 4] * s8, oa[8 * j + 5] * s8, oa[8 * j + 6] * s8, oa[8 * j + 7] * s8);
          *(GAS unsigned long long*)(orow + head * 128 + d0 + 8 * j) = (unsigned long long)lo | ((unsigned long long)hi << 32); } }
}
__device__ __forceinline__ constexpr int cand_a(int ci) { return ci < 16 ? 0 : ci < 24 ? 1 : ci < 29 ? 2 : ci < 33 ? 3 : ci < 36 ? 4 : ci < 38 ? 5 : ci < 40 ? 6 : ci < 42 ? 7 : ci - 34; }
__device__ __forceinline__ constexpr int cand_b(int ci) { return ci < 16 ? ci : ci < 24 ? ci - 16 : ci < 29 ? ci - 24 : ci < 33 ? ci - 29 : ci < 36 ? ci - 33 : ci < 38 ? ci - 36 : ci < 40 ? ci - 38 : ci < 42 ? ci - 40 : 0; }
__device__ __forceinline__ float max3f(float a, float b, float c) { return fmaxf(a, fmaxf(b, c)); }
__device__ __forceinline__ int sortable_i(float f) { const int b = __float_as_int(f); return b ^ ((b >> 31) & 0x7FFFFFFF); }
__device__ __forceinline__ float unsortable_f(int k) { return __int_as_float(k ^ ((k >> 31) & 0x7FFFFFFF)); }
__device__ __forceinline__ void sort16_desc(int (&x)[16]) {
#pragma unroll
    for (int k = 2; k <= 16; k <<= 1)
#pragma unroll
        for (int j = k >> 1; j > 0; j >>= 1)
#pragma unroll
            for (int i = 0; i < 16; ++i) { const int l = i ^ j; if (l > i) { const int hi = max(x[i], x[l]), lo = min(x[i], x[l]); if ((i & k) == 0) { x[i] = hi; x[l] = lo; } else { x[i] = lo; x[l] = hi; } } }
}
__device__ __forceinline__ void merge16_desc(int (&x)[16]) {
#pragma unroll
    for (int j = 8; j > 0; j >>= 1)
#pragma unroll
        for (int i = 0; i < 16; ++i) { const int l = i ^ j; if (l > i) { const int hi = max(x[i], x[l]), lo = min(x[i], x[l]); x[i] = hi; x[l] = lo; } }
}
constexpr int RT_STR = 272;
__device__ __forceinline__ void peer_route(Frame& F, int tok0, int h, const LAS unsigned char* skl, int* REg, float* RGg) {
    const int lane = F.lane, n = lane & 15, rq = lane >> 4;
    const float NINF = -__builtin_inff();
    float top[2][16];
#pragma unroll
    for (int p = 0; p < 2; ++p) {
        f32x4 sc[8];
#pragma unroll
        for (int mt = 0; mt < 8; ++mt) sc[mt] = (f32x4){0.f, 0.f, 0.f, 0.f};
        const bf16* qp = F.pq + (size_t)(tok0 + n) * PQ_LD + h * 256 + p * 128 + 8 * rq;
        int koff = (p * 128 + n) * RT_STR + 16 * rq; asm volatile("" : "+v"(koff));
        const LAS unsigned char* kp = skl + koff;
#pragma unroll
        for (int ks = 0; ks < 4; ++ks) { const bf16x8 qb = *(const GAS bf16x8*)(qp + 32 * ks);
#pragma unroll
            for (int mt = 0; mt < 8; ++mt) { const bf16x8 kf = *(const LAS bf16x8*)(kp + mt * 16 * RT_STR + 64 * ks); sc[mt] = MFMA16(kf, qb, sc[mt]); }
            CBAR(); }
        int va[16], vb[16];
        unsigned rq4 = 4u * (unsigned)rq; asm volatile("" : "+v"(rq4));
#pragma unroll
        for (int mt = 0; mt < 8; ++mt)
#pragma unroll
            for (int e = 0; e < 4; ++e) { const unsigned idx = 16 * mt + rq4 + e; const int key = sortable_i(__uint_as_float((__float_as_uint(sc[mt][e]) & ~127u) | (127u - idx)));
                if (mt < 4) va[mt * 4 + e] = key; else vb[(mt - 4) * 4 + e] = key; }
        sort16_desc(va); sort16_desc(vb);
#pragma unroll
        for (int i = 0; i < 16; ++i) va[i] = max(va[i], vb[15 - i]);
        merge16_desc(va);
#pragma unroll
        for (int lv = 16; lv <= 32; lv <<= 1) {
#pragma unroll
            for (int i = 0; i < 16; ++i) vb[i] = __shfl_xor(va[15 - i], lv);
#pragma unroll
            for (int i = 0; i < 16; ++i) va[i] = max(va[i], vb[i]);
            merge16_desc(va);
        }
#pragma unroll
        for (int rd = 0; rd < 16; ++rd) top[p][rd] = unsortable_f(va[rd]);
    }
    int i1v[16], i2v[16];
#pragma unroll
    for (int a = 0; a < 16; ++a) { i1v[a] = 127 - (int)(__float_as_uint(top[0][a]) & 127u); i2v[a] = 127 - (int)(__float_as_uint(top[1][a]) & 127u); }
    float val[13]; int eid[13];
#pragma unroll
    for (int k = 0; k < 13; ++k) { val[k] = NINF; eid[k] = -1;
#pragma unroll
        for (int q = 0; q < 4; ++q) { const int ci = 4 * k + q;
            if (ci < 50) { const float s = top[0][cand_a(ci)] + top[1][cand_b(ci)]; const float sk = __uint_as_float((__float_as_uint(s) & ~63u) | (unsigned)(63 - ci)); const int e = i1v[cand_a(ci)] * 128 + i2v[cand_b(ci)];
                if (rq == q) { val[k] = sk; eid[k] = e; } } } }
    float ws[16]; int we[16];
#pragma unroll
    for (int rd = 0; rd < 16; ++rd) {
        float best = val[0];
#pragma unroll
        for (int k = 1; k < 13; ++k) best = fmaxf(best, val[k]);
        best = fmaxf(best, __shfl_xor(best, 16)); best = fmaxf(best, __shfl_xor(best, 32));
        int es = -1;
#pragma unroll
        for (int k = 0; k < 13; ++k) { const bool m = (val[k] == best); es = m ? eid[k] : es; val[k] = m ? NINF : val[k]; }
        es = max(es, __shfl_xor(es, 16)); es = max(es, __shfl_xor(es, 32));
        ws[rd] = best; we[rd] = es;
    }
    float ex[16]; float sum = 0.f;
#pragma unroll
    for (int k = 0; k < 16; ++k) { ex[k] = expf(ws[k] - ws[0]); sum += ex[k]; }
    const float inv = 1.f / sum;
    if (rq == 0) {
        int* rep = REg + (size_t)(tok0 + n) * 128 + h * 16; float* rgp = RGg + (size_t)(tok0 + n) * 128 + h * 16;
#pragma unroll
        for (int k = 0; k < 16; k += 4) { *(GAS v4u*)(rep + k) = (v4u){(unsigned)we[k], (unsigned)we[k + 1], (unsigned)we[k + 2], (unsigned)we[k + 3]};
            *(GAS f32x4*)(rgp + k) = (f32x4){ex[k] * inv, ex[k + 1] * inv, ex[k + 2] * inv, ex[k + 3] * inv}; }
    }
}
__device__ __forceinline__ void route_phase(Frame& FF) {
    for (int unit = blockIdx.x; unit < 8 * (NTOK / 128); unit += FF.G) {
        Frame F = FF; unsigned z_ = 0u; asm volatile("" : "+v"(z_)); const int ln_ = (int)__builtin_amdgcn_mbcnt_hi(~0u, __builtin_amdgcn_mbcnt_lo(~0u, z_)); F.lane = ln_; F.tid = FF.wave * 64 + ln_;
        const int h = unit & 7, tg = unit >> 3;
        const bf16* src = F.sk + (size_t)h * 2 * 128 * 128;
#pragma unroll
        for (int i = 0; i < 8; ++i) { const int c = F.tid + 512 * i, row = c >> 4, ch = c & 15; *(LAS v4u*)(F.lds + row * RT_STR + ch * 16) = *(const GAS v4u*)(src + row * 128 + ch * 8); }
        __syncthreads();
        peer_route(F, tg * 128 + 16 * F.wave, h, F.lds, F.reg, F.rgg);
        __syncthreads();
    }
}
constexpr int PX_STR = 4112;
constexpr int PL_XQ = 0, PL_G2 = 16 * PX_STR, PL_LNF = PL_G2 + 16384, PL_RE = PL_LNF + 16384, PL_RG = PL_RE + 8192, PL_ACT = PL_RG + 8192, PL_SKEY = PL_ACT + 8192,
              PL_HIST = PL_SKEY + 8192, PL_PREF = PL_HIST + 1024, PL_SXI = PL_PREF + 1024, PL_XS = PL_SXI + 256, PL_WSCR = PL_XS + 512, PL_END = PL_WSCR + 8 * 1536;
static_assert(PL_END <= LDSCTL_OFF, "PEER LDS map");
__device__ __forceinline__ void peer_quant_token(Frame& F, int tok, LAS unsigned char* xq, LAS float* sxi_slot, LAS int* xs_row) {
    const int lane = F.lane; const signed char* src = F.h8 + (size_t)tok * DM;
    unsigned long long w[8];
#pragma unroll
    for (int j = 0; j < 8; ++j) w[j] = *(const GAS unsigned long long*)(src + j * 512 + lane * 8);
    if (lane == 0) *sxi_slot = F.sah[tok];
#pragma unroll
    for (int j = 0; j < 8; ++j) { *(LAS unsigned long long*)(xq + j * 512 + lane * 8) = w[j]; const int lo = (int)(unsigned)w[j], hi = (int)(unsigned)(w[j] >> 32);
        int sm = ((lo << 24) >> 24) + ((lo << 16) >> 24) + ((lo << 8) >> 24) + (lo >> 24) + ((hi << 24) >> 24) + ((hi << 16) >> 24) + ((hi << 8) >> 24) + (hi >> 24);
        sm = wave_sum_i(sm); if (lane == 0) xs_row[j] = sm; }
}
__device__ __forceinline__ void peer_token_v(Frame& F, int tok, int tl, const LAS unsigned* skey, const LAS float* act_all, LAS unsigned char* wl, const LAS float* g2, const LAS float* lnf, const bf16* x1) {
    const int lane = F.lane;
    LAS int* se = (LAS int*)wl; LAS float* sa = (LAS float*)(wl + 512);
    { int cnt = 0;
#pragma unroll 4
      for (int it = 0; it < 32; ++it) { const unsigned key = skey[it * 64 + lane]; const bool m = (int)((key >> 7) & 15u) == tl;
          const unsigned long long bm = __ballot(m); const int pos = cnt + (int)__builtin_amdgcn_mbcnt_hi((unsigned)(bm >> 32), __builtin_amdgcn_mbcnt_lo((unsigned)bm, 0u));
          if (m) { se[pos] = (int)(key >> 11); sa[pos] = act_all[key & 2047u]; } cnt += __popcll(bm); } }
    LDS_WAIT(); CBAR();
    f32x2v outv[32];
#pragma unroll
    for (int k = 0; k < 32; ++k) outv[k] = (f32x2v){0.f, 0.f};
#define PV_LOAD(c0_, c1_, cs_, kk_) { const int kq_ = (kk_) < 127 ? (kk_) : 127; const int e_ = __builtin_amdgcn_readfirstlane(se[kq_]); const unsigned char* vp_ = F.v8 + (size_t)e_ * PV_ROW; \
      c0_ = *(const GAS v4u*)(vp_ + lane * 16); c1_ = *(const GAS v4u*)(vp_ + 1024 + lane * 16); CBAR(); }
#define PV_FMA(c0_, c1_, cs_, kk_) { const float act_ = sa[kk_]; const f32x2v c2_ = (f32x2v){act_, act_}; \
      const unsigned w_[8] = {c0_.x, c0_.y, c0_.z, c0_.w, c1_.x, c1_.y, c1_.z, c1_.w}; \
      _Pragma("unroll") for (int d = 0; d < 8; ++d) { \
        outv[4 * d + 0] = __builtin_elementwise_fma(__builtin_amdgcn_cvt_scalef32_pk_f32_fp4(w_[d], 1.0f, 0), c2_, outv[4 * d + 0]);        \
        outv[4 * d + 1] = __builtin_elementwise_fma(__builtin_amdgcn_cvt_scalef32_pk_f32_fp4(w_[d], 1.0f, 1), c2_, outv[4 * d + 1]); \
        outv[4 * d + 2] = __builtin_elementwise_fma(__builtin_amdgcn_cvt_scalef32_pk_f32_fp4(w_[d], 1.0f, 2), c2_, outv[4 * d + 2]); \
        outv[4 * d + 3] = __builtin_elementwise_fma(__builtin_amdgcn_cvt_scalef32_pk_f32_fp4(w_[d], 1.0f, 3), c2_, outv[4 * d + 3]); } }
    { v4u a0, a1, b0, b1, c0, c1, d0, d1; const unsigned as = 0u, bs = 0u, cs = 0u, ds = 0u; (void)as; (void)bs; (void)cs; (void)ds;
      PV_LOAD(a0, a1, as, 0) PV_LOAD(b0, b1, bs, 1) PV_LOAD(c0, c1, cs, 2)
#pragma unroll 1
      for (int k = 0; k < 128; k += 4) {
          PV_LOAD(d0, d1, ds, k + 3) PV_FMA(a0, a1, as, k)
          PV_LOAD(a0, a1, as, k + 4) PV_FMA(b0, b1, bs, k + 1)
          PV_LOAD(b0, b1, bs, k + 5) PV_FMA(c0, c1, cs, k + 2)
          PV_LOAD(c0, c1, cs, k + 6) PV_FMA(d0, d1, ds, k + 3)
      } }
#undef PV_LOAD
#undef PV_FMA
    float ss = 0.f;
    int lt = lane; asm volatile("" : "+v"(lt));
#pragma unroll
    for (int j = 0; j < 2; ++j) {
#pragma unroll
        for (int i = 0; i < 8; ++i) { const int k = j * 2048 + 256 * i + 4 * lt; const unsigned long long xw = *(const GAS unsigned long long*)(x1 + (size_t)tok * DM + k); const unsigned xl = (unsigned)xw, xh = (unsigned)(xw >> 32); const f32x4 xv = {bf_lo(xl), bf_hi(xl), bf_lo(xh), bf_hi(xh)}; const f32x4 gv = *(const LAS f32x4*)(g2 + k);
            f32x2v y0 = outv[16 * j + 2 * i], y1 = outv[16 * j + 2 * i + 1];
            y0.x = xv[0] + gv[0] * y0.x; y0.y = xv[1] + gv[1] * y0.y; y1.x = xv[2] + gv[2] * y1.x; y1.y = xv[3] + gv[3] * y1.y;
            outv[16 * j + 2 * i] = y0; outv[16 * j + 2 * i + 1] = y1; ss += (y0.x * y0.x + y0.y * y0.y) + (y1.x * y1.x + y1.y * y1.y); } }
    const float rs = 1.0f / sqrtf(wave_sum(ss) * (1.f / DM) + NORM_EPS);
#pragma unroll
    for (int j = 0; j < 2; ++j) {
#pragma unroll
        for (int i = 0; i < 8; ++i) { const int k = j * 2048 + 256 * i + 4 * lt; const f32x4 lv = *(const LAS f32x4*)(lnf + k); const f32x2v y0 = outv[16 * j + 2 * i], y1 = outv[16 * j + 2 * i + 1];
            const f32x4 y = {y0.x * rs * lv[0], y0.y * rs * lv[1], y1.x * rs * lv[2], y1.y * rs * lv[3]};
            *(GAS f32x4*)(F.out + (size_t)tok * DM + k) = y; } }
}
__device__ __forceinline__ void peer_phase(Frame& FF, const bf16* x1) {
    LAS unsigned char* L = FF.lds;
    LAS unsigned char* XQ = L + PL_XQ; LAS float* g2 = (LAS float*)(L + PL_G2); LAS float* lnf = (LAS float*)(L + PL_LNF); LAS int* RE = (LAS int*)(L + PL_RE); LAS float* RG = (LAS float*)(L + PL_RG);
    LAS float* ACT = (LAS float*)(L + PL_ACT); LAS unsigned* SKEY = (LAS unsigned*)(L + PL_SKEY); LAS int* HIST = (LAS int*)(L + PL_HIST); LAS int* PREF = (LAS int*)(L + PL_PREF);
    LAS float* SXI = (LAS float*)(L + PL_SXI); LAS int* XS = (LAS int*)(L + PL_XS);
    { int t0 = FF.wave * 64 + (int)__builtin_amdgcn_mbcnt_hi(~0u, __builtin_amdgcn_mbcnt_lo(~0u, 0u)); asm volatile("" : "+v"(t0)); for (int i = t0; i < DM; i += NWAVES * 64) lnf[i] = FF.lnfg[i]; }
    for (int unit = blockIdx.x; unit < NTOK / 16; unit += FF.G) {
        Frame F = FF; unsigned z_ = 0u; asm volatile("" : "+v"(z_)); const int ln_ = (int)__builtin_amdgcn_mbcnt_hi(~0u, __builtin_amdgcn_mbcnt_lo(~0u, z_)); F.lane = ln_; F.tid = FF.wave * 64 + ln_; const int tid = F.tid;
        const int lane = F.lane, n = lane & 15, kg = lane >> 4;
        LAS unsigned char* WL = L + PL_WSCR + F.wave * 1536;
        const int tok0 = unit * 16, b = tok0 >> 12;
        for (int i = tid; i < DM; i += NWAVES * 64) g2[i] = F.modp[(size_t)b * NADA + 5 * DM + i];
        { const int i = tid; ((LAS v4u*)RE)[i] = *((const GAS v4u*)(F.reg + (size_t)tok0 * 128) + i); ((LAS f32x4*)RG)[i] = *((const GAS f32x4*)(F.rgg + (size_t)tok0 * 128) + i); }
#pragma unroll 1
        for (int tt = 0; tt < 2; ++tt) peer_quant_token(F, tok0 + 2 * F.wave + tt, XQ + (2 * F.wave + tt) * PX_STR, SXI + 2 * F.wave + tt, XS + (2 * F.wave + tt) * 8);
        if (tid < 256) HIST[tid] = 0;
#pragma unroll
        for (int i = 0; i < 4; ++i) ACT[tid + 512 * i] = 0.f;
        __syncthreads();
        unsigned key[4]; int pos[4];
#pragma unroll
        for (int i = 0; i < 4; ++i) { const int p = tid + 512 * i; const int e = RE[p]; key[i] = ((unsigned)e << 11) | (unsigned)p; pos[i] = __hip_atomic_fetch_add(HIST + (e >> 6), 1, __ATOMIC_RELAXED, __HIP_MEMORY_SCOPE_WORKGROUP); }
        __syncthreads();
        if (F.wave == 0) { const int h0 = HIST[4 * lane], h1 = HIST[4 * lane + 1], h2 = HIST[4 * lane + 2], h3 = HIST[4 * lane + 3]; const int v = h0 + h1 + h2 + h3; int inc = v;
#pragma unroll
            for (int o = 1; o < 64; o <<= 1) { const int up = __builtin_amdgcn_ds_bpermute(((lane - o) & 63) << 2, inc); if (lane >= o) inc += up; }
            const int ex = inc - v; PREF[4 * lane] = ex; PREF[4 * lane + 1] = ex + h0; PREF[4 * lane + 2] = ex + h0 + h1; PREF[4 * lane + 3] = ex + h0 + h1 + h2; }
        __syncthreads();
#pragma unroll
        for (int i = 0; i < 4; ++i) SKEY[PREF[key[i] >> 17] + pos[i]] = key[i];
        __syncthreads();
        {
            const int koff = F.wave * 256 + 16 * kg;
#define PU_LOAD(buf, key_, g_) { key_ = SKEY[16 * ((g_) < 127 ? (g_) : 127) + n]; const unsigned char* up_ = F.u8 + (size_t)(key_ >> 11) * (DM / 2) + koff; \
              buf[0] = *(const GAS v4u*)(up_); buf[1] = *(const GAS v4u*)(up_ + 64); buf[2] = *(const GAS v4u*)(up_ + 128); buf[3] = *(const GAS v4u*)(up_ + 192); CBAR(); }
#define PU_MMA(buf, key_) { const int p = (int)(key_ & 2047u), tl = p >> 7; const LAS unsigned char* xb = XQ + tl * PX_STR + F.wave * 512 + 16 * kg; \
              pg8::i32x4 acc = (pg8::i32x4){0, 0, 0, 0}; \
              _Pragma("unroll") for (int m = 0; m < 4; ++m) { const v4u uw = buf[m]; const pg8::i32x4 x0 = *(const LAS pg8::i32x4*)(xb + 128 * m), x1q = *(const LAS pg8::i32x4*)(xb + 128 * m + 64); \
                  const pg8::i32x4 alo = {(int)(uw.x & 0x0F0F0F0Fu), (int)(uw.y & 0x0F0F0F0Fu), (int)(uw.z & 0x0F0F0F0Fu), (int)(uw.w & 0x0F0F0F0Fu)}; \
                  const pg8::i32x4 ahi = {(int)((uw.x >> 4) & 0x0F0F0F0Fu), (int)((uw.y >> 4) & 0x0F0F0F0Fu), (int)((uw.z >> 4) & 0x0F0F0F0Fu), (int)((uw.w >> 4) & 0x0F0F0F0Fu)}; \
                  acc = __builtin_amdgcn_mfma_i32_16x16x64_i8(alo, x0, acc, 0, 0, 0); acc = __builtin_amdgcn_mfma_i32_16x16x64_i8(ahi, x1q, acc, 0, 0, 0); } \
              if (kg == (n >> 2)) { const int r = n & 3; const int ai = r == 0 ? acc[0] : r == 1 ? acc[1] : r == 2 ? acc[2] : acc[3];        \
                  const float a = (float)ai - 7.5f * (float)XS[tl * 8 + F.wave];                                                              \
                  __hip_atomic_fetch_add(ACT + p, a, __ATOMIC_RELAXED, __HIP_MEMORY_SCOPE_WORKGROUP); } }
            v4u ua[4], ubb[4], uc[4]; unsigned ka, kb2, kc;
            PU_LOAD(ua, ka, 0) PU_LOAD(ubb, kb2, 1)
#pragma unroll 1
            for (int gi = 0; gi < 126; gi += 3) {
                PU_LOAD(uc, kc, gi + 2) PU_MMA(ua, ka)
                PU_LOAD(ua, ka, gi + 3) PU_MMA(ubb, kb2)
                PU_LOAD(ubb, kb2, gi + 4) PU_MMA(uc, kc)
            }
            PU_MMA(ua, ka) PU_MMA(ubb, kb2)
#undef PU_LOAD
#undef PU_MMA
        }
        __syncthreads();
#pragma unroll
        for (int i = 0; i < 4; ++i) { const int p = tid + 512 * i; const int e = RE[p]; const float av = ACT[p] * SXI[p >> 7] * F.usc[e];
            ACT[p] = 0.5f * av * (1.f + erff(av * 0.70710678118654752f)) * RG[p] * F.usc[NEXP + e]; }
        __syncthreads();
#pragma unroll 1
        for (int tt = 0; tt < 2; ++tt) { const int tl = 2 * F.wave + tt; peer_token_v(F, tok0 + tl, tl, SKEY, ACT, WL, g2, lnf, x1); }
        __syncthreads();
    }
}
struct Args { const void* in[14]; float* out; unsigned char* ws; int ph_lo, ph_hi; };
__global__ void __launch_bounds__(NWAVES * 64, 2) fwd_kernel(Args args) {
    extern __shared__ __attribute__((aligned(16))) unsigned char lds_raw[];
    Frame F;
    F.lds = (LAS unsigned char*)lds_raw;
    F.MISC = (volatile LAS unsigned*)(F.lds + MISC_OFF);
    F.tid = threadIdx.x; F.lane = F.tid & 63; F.wave = __builtin_amdgcn_readfirstlane(F.tid >> 6); F.G = gridDim.x;
    unsigned char* ws = args.ws;
    F.ctl = (gu32*)(ws + WS_CTL);
    F.x = (const float*)args.in[0]; F.c = (const float*)args.in[1]; F.pos = (const int*)args.in[2]; F.ln1g = (const float*)args.in[3]; F.ln2g = (const float*)args.in[4];
    F.w_ada = (const float*)args.in[5]; F.b_ada = (const float*)args.in[6]; F.w_in = (const float*)args.in[7]; F.w_out = (const float*)args.in[8]; F.wq = (const float*)args.in[9];
    F.subk = (const float*)args.in[10]; F.pu = (const float*)args.in[11]; F.pv = (const float*)args.in[12]; F.lnfg = (const float*)args.in[13]; F.out = args.out;
    F.modp = (float*)(ws + WS_MODP); F.cosH = (float*)(ws + WS_COSH); F.sinH = (float*)(ws + WS_SINH); F.cosI = (float*)(ws + WS_COSI); F.sinI = (float*)(ws + WS_SINI);
    F.lse = (float*)(ws + WS_LSE); F.score = (float*)(ws + WS_SCORE); F.x1 = (bf16*)(ws + WS_X1);
    F.sk = (bf16*)(ws + WS_SK); F.win = (bf16*)(ws + WS_WIN); F.wout = (bf16*)(ws + WS_WOUT); F.wqt = (bf16*)(ws + WS_WQ); F.h = (bf16*)(ws + WS_H); F.reg = (int*)(ws + WS_H); F.rgg = (float*)(ws + WS_H + 4 * MiB); F.proj = (bf16*)(ws + WS_PROJ);
    F.oap = (bf16*)(ws + WS_OAP); F.o = (bf16*)(ws + WS_O); F.pq = (bf16*)(ws + WS_PQ); F.u8 = ws + WS_U16; F.v8 = ws + WS_V16; F.usc = (float*)(ws + WS_USC); F.h8 = (signed char*)(ws + WS_H8); F.wq8 = (signed char*)(ws + WS_WQ8); F.sah = (float*)(ws + WS_SAH); F.sbq = (float*)(ws + WS_SBQ); F.win8 = (signed char*)(ws + WS_WIN8); F.o8 = (signed char*)(ws + WS_O); F.wout8 = (signed char*)(ws + WS_WOUT8); F.sao = (float*)(ws + WS_SAO); F.sbo = (float*)(ws + WS_SBO); F.sbin = (float*)(ws + WS_SBIN);
    for (int u = F.tid; u < (LDS_BYTES - LDSCTL_OFF) / 4; u += NWAVES * 64) ((LAS unsigned*)(F.lds + LDSCTL_OFF))[u] = 0u;
    __syncthreads();
    XcdBarrier bar = xcd_barrier_post((unsigned*)(F.ctl + CW_BAR), F.MISC + 8);
    const int lo = args.ph_lo, hi = args.ph_hi;
#ifndef PHMASK
#define PHMASK 0x3ff
#endif
#define IN(k) (((PHMASK >> (k)) & 1) && lo <= (k) && (k) < hi)
#define SEAM(k) do { if (IN(k) && IN((k) + 1)) xcd_barrier(bar); } while (0)
#define FRESH_LANE() do { int l_ = (int)__builtin_amdgcn_mbcnt_hi(~0u, __builtin_amdgcn_mbcnt_lo(~0u, 0u)); asm volatile("" : "+v"(l_)); F.lane = l_; F.tid = F.wave * 64 + l_; } while (0)

    if (IN(0)) { FRESH_LANE(); p0_gemv(F); p0_items(F); }
    SEAM(0);
    if (IN(1)) {
#if MIX_ENABLE
        FRESH_LANE();
        modnorm_phase(F, F.x, F.ln1g, 0, 1, nullptr, F.h8, F.sah);
        { const int gw = blockIdx.x * NWAVES + F.wave, NGW = F.G * NWAVES;
          for (int r = gw; r < PROJ_LD; r += NGW) quant_row_bf16_i8(F.win + (size_t)r * DM, F.win8 + (size_t)r * DM, F.sbin + r, F.lane); }
#endif
    }
    SEAM(1);
    if (IN(2)) {
#if MIX_ENABLE
        pg8::Gemm g{(const pg8::bf16_t*)F.h8, (const pg8::bf16_t*)F.win8, NTOK, PROJ_LD, DM / 2}; pg8::StaticOrder S; S.init(NTOK, PROJ_LD, F.G, (int)blockIdx.x);
        pg8::EpiProjI8 E{F.proj, PROJ_LD, F.cosH, F.sinH, F.cosI, F.sinI, F.sah, F.sbin};
        pg8::gemm_phase_i8<pg8::EpiProjI8, pg8::StaticOrder, true, true>(F.lds + RING_OFF, g, S, E);
        { const int nwg = (NTOK / 256) * (PROJ_LD / 256), rem = nwg % F.G;
          if (rem != 0) { FRESH_LANE();
              const int nearly = (F.G - rem) * NWAVES, nslots = 2 * nearly + rem * NWAVES; const bool early = (int)blockIdx.x >= rem;
              const int s0 = early ? 2 * (((int)blockIdx.x - rem) * NWAVES + F.wave) : 2 * nearly + (int)blockIdx.x * NWAVES + F.wave;
              for (int it = s0; it < NITEMS_B; it += nslots) { conv_item_b(F, it, (LAS float*)(F.lds + F.wave * 16640)); if (early && it + 1 < NITEMS_B) conv_item_b(F, it + 1, (LAS float*)(F.lds + F.wave * 16640)); } }
          else if (rem == 0) { FRESH_LANE(); const int gw = blockIdx.x * NWAVES + F.wave, NGW = F.G * NWAVES; for (int it = gw; it < NITEMS_B; it += NGW) conv_item_b(F, it, (LAS float*)(F.lds + F.wave * 16640)); } }
#endif
    }
    SEAM(2);
    if (IN(3)) {
#if MIX_ENABLE
        FRESH_LANE();
        { gu32* ctr = F.ctl + 64; int u = p3_next(F, ctr);
          while (u < 320) { idx_unit(F, 319 - u); u = p3_next(F, ctr); }
          dil_units(F, u - 320, ctr, 1536); }
#endif
    }
    SEAM(3);
    if (IN(4)) {
#if MIX_ENABLE
        FRESH_LANE();
        const int gw = blockIdx.x * NWAVES + F.wave, NGW = F.G * NWAVES;
        LAS unsigned char* wl = F.lds + F.wave * DSA_WLDS;
        for (int i = gw; i < NTOK; i += NGW) { const int b = i >> 12, r = i & (SEQ - 1); const int t = ((r ^ (r >> 2) ^ (r >> 11)) & 1) ? (SEQ - 1 - (r >> 1)) : (r >> 1); dsa_token(F, b, t, wl); }
        for (int r = gw; r < DM; r += NGW) quant_row_bf16_i8(F.wout + (size_t)r * DM, F.wout8 + (size_t)r * DM, F.sbo + r, F.lane);
        __syncthreads();
#endif
    }
    SEAM(4);
    if (IN(5)) {
#if MIX_ENABLE
        pg8::Gemm g{(const pg8::bf16_t*)F.o8, (const pg8::bf16_t*)F.wout8, NTOK, DM, DM / 2}; pg8::StaticOrder S; S.init(NTOK, DM, F.G, (int)blockIdx.x);
        pg8::EpiResI8 E{F.x, (pg8::bf16_t*)F.x1, DM, F.modp, F.b_ada, 2 * DM, NADA, SEQ / 256, F.sao, F.sbo};
        pg8::gemm_phase_i8<pg8::EpiResI8, pg8::StaticOrder, true, true>(F.lds + RING_OFF, g, S, E);
#endif
    }
    SEAM(5);
    static_assert(MIX_ENABLE, "the residual stream after the mixers is the bf16 buffer x1");
    const bf16* x1 = F.x1;
    if (IN(6)) { FRESH_LANE(); modnorm_phase(F, x1, F.ln2g, 3, 4, nullptr, F.h8, F.sah);
        { const int gw = blockIdx.x * NWAVES + F.wave, NGW = F.G * NWAVES;
          for (int r = gw; r < PQ_LD; r += NGW) quant_row_bf16_i8(F.wqt + (size_t)r * DM, F.wq8 + (size_t)r * DM, F.sbq + r, F.lane); } }
    SEAM(6);
    if (IN(7)) {
        pg8::Gemm g{(const pg8::bf16_t*)F.h8, (const pg8::bf16_t*)F.wq8, NTOK, PQ_LD, DM / 2}; pg8::StaticOrder S; S.init(NTOK, PQ_LD, F.G, (int)blockIdx.x);
        pg8::EpiStoreBf16I8 E{F.pq, PQ_LD, F.sah, F.sbq};
        pg8::gemm_phase_i8<pg8::EpiStoreBf16I8, pg8::StaticOrder, true, true>(F.lds + RING_OFF, g, S, E);
    }
    SEAM(7);
    if (IN(8)) { FRESH_LANE(); route_phase(F); }
    SEAM(8);
    if (IN(9)) { FRESH_LANE(); peer_phase(F, x1); }
#undef IN
#undef SEAM
}

#ifndef N_LAUNCHES
#define N_LAUNCHES 1
#endif
extern "C" void kernel_launch(void* const* d_in, const int* in_sizes, int n_in, void* d_out, int out_size, void* d_ws, size_t ws_size, hipStream_t stream) {
    static int grid = 0;
    if (grid == 0) {
        if (n_in != 14 || out_size != NTOK * DM || ws_size < WS_END) { fprintf(stderr, "kernel_launch: unexpected shapes (n_in %d, out %d, ws %zu)\n", n_in, out_size, ws_size); grid = -1; return; }
        int dev = 0, cus = 0, per_cu = 0;
        if (hipGetDevice(&dev) != hipSuccess || hipDeviceGetAttribute(&cus, hipDeviceAttributeMultiprocessorCount, dev) != hipSuccess) { grid = -1; return; }
        if (hipFuncSetAttribute((const void*)fwd_kernel, hipFuncAttributeMaxDynamicSharedMemorySize, LDS_BYTES) != hipSuccess) { fprintf(stderr, "kernel_launch: hipFuncSetAttribute failed\n"); grid = -1; return; }
        if (hipOccupancyMaxActiveBlocksPerMultiprocessor(&per_cu, (const void*)fwd_kernel, NWAVES * 64, LDS_BYTES) != hipSuccess || per_cu < 1) fprintf(stderr, "kernel_launch: occupancy query reports %d\n", per_cu);
        (void)hipGetLastError();
        grid = cus;
    }
    if (grid < 0) return;
    (void)hipMemsetAsync((char*)d_ws + WS_CTL, 0, CTL_ZERO_BYTES, stream);
    Args a{};
    for (int i = 0; i < 14; ++i) a.in[i] = d_in[i];
    a.out = (float*)d_out; a.ws = (unsigned char*)d_ws;
#if N_LAUNCHES == 1
    a.ph_lo = 0; a.ph_hi = 10;
    hipLaunchKernelGGL(fwd_kernel, dim3(grid), dim3(NWAVES * 64), LDS_BYTES, stream, a);
#ifdef PROBE_PHASE
    a.ph_lo = PROBE_PHASE; a.ph_hi = PROBE_PHASE + 1;
    hipLaunchKernelGGL(fwd_kernel, dim3(grid), dim3(NWAVES * 64), LDS_BYTES, stream, a);
#endif
#else
    for (int p = 0; p < 10; ++p) { a.ph_lo = p; a.ph_hi = p + 1; hipLaunchKernelGGL(fwd_kernel, dim3(grid), dim3(NWAVES * 64), LDS_BYTES, stream, a); }
#endif
}
```

```cpp
#include <hip/hip_runtime.h>
#include <cstdio>
#include <cstdint>
#include <type_traits>
namespace pg8 {
#define PG8_LAS __attribute__((address_space(3)))
typedef unsigned short bf16_t;
typedef short bf16x8 __attribute__((ext_vector_type(8)));
typedef float f32x4 __attribute__((ext_vector_type(4)));
typedef unsigned u32x4 __attribute__((ext_vector_type(4)));
constexpr int BM = 256, BK = 64, HALF = 128, HTB = HALF * BK * 2  , STAGE_BYTES = 8 * HTB, NXCD = 8, WGM = 8;

__host__ __device__ __forceinline__ int lds_byte(int r, int c) { const int st = (r >> 4) * 2 + (c >> 5), rr = r & 15, cc = c & 31, ob = rr * 64 + cc * 2; return st * 1024 + (ob ^ (((ob >> 9) & 1) << 5)); }
__host__ __device__ __forceinline__ void stage_rc(int b, int& R, int& C) { const int st = b / 1024, sb = b % 1024, swz = sb ^ (((sb >> 9) & 1) << 5); R = (st >> 1) * 16 + swz / 64; C = (st & 1) * 32 + (swz % 64) / 2; }
__host__ __device__ __forceinline__ int perm32(int rho) { const int n = rho >> 4, i = rho & 15; return 8 * (i >> 2) + 4 * n + (i & 3); }

struct Unit { int pm, pn; };
struct Gemm { const bf16_t* A; const bf16_t* Bt; int M, N, K; };

struct StaticOrder {
    int nM, nN, nwg, G, c;
    __host__ __device__ void init(int M, int N, int G_, int c_) { nM = M / BM; nN = N / BM; nwg = nM * nN; G = G_; c = c_; }
    __host__ __device__ bool next(int i, Unit& u) const {
        const long L = (long)i * G + c; if (L >= nwg) return false;
        int wgid = (int)L; { const int q = nwg / NXCD, r = nwg % NXCD, xcd = wgid % NXCD, off = wgid / NXCD; wgid = (xcd < r ? xcd * (q + 1) : r * (q + 1) + (xcd - r) * q) + off; }
        const int nig = WGM * nN, gid = wgid / nig, fm = gid * WGM, gsz = (nM - fm) < WGM ? (nM - fm) : WGM;
        u.pm = fm + ((wgid % nig) % gsz); u.pn = (wgid % nig) / gsz; return true;
    }
    __device__ __forceinline__ void a_ready(const Unit&) const {}
    __device__ __forceinline__ void done(const Unit&) const {}
};

__device__ __forceinline__ unsigned cvt_pk_bf16(float lo, float hi) { unsigned r; asm volatile("v_cvt_pk_bf16_f32 %0, %1, %2" : "=v"(r) : "v"(lo), "v"(hi)); return r; }
typedef float f32x2 __attribute__((ext_vector_type(2)));
struct EpiStoreBf16 {
    static constexpr bool PERM = true, AFTER_DRAIN = false;
    bf16_t* O; int ldc;
    __device__ __forceinline__ void operator()(const f32x4 (&acc)[2][2][4][2], const Unit& u, int wr, int wc, int fr, int fq) const {
        const int row0 = u.pm * BM + wr * 64 + fr, col0 = u.pn * BM + wc * 32 + 8 * fq;
#pragma unroll
        for (int ai = 0; ai < 2; ++ai)
#pragma unroll
            for (int m = 0; m < 4; ++m) { bf16_t* rowp = O + (size_t)(row0 + ai * HALF + m * 16) * ldc + col0;
#pragma unroll
                for (int bj = 0; bj < 2; ++bj) { const f32x4 v0 = acc[ai][bj][m][0], v1 = acc[ai][bj][m][1];
                    u32x4 w; w.x = cvt_pk_bf16(v0[0], v0[1]); w.y = cvt_pk_bf16(v0[2], v0[3]); w.z = cvt_pk_bf16(v1[0], v1[1]); w.w = cvt_pk_bf16(v1[2], v1[3]);
                    *(u32x4*)(rowp + bj * HALF) = w; } }
    }
};
struct EpiProj {
    static constexpr bool PERM = true, AFTER_DRAIN = false;
    bf16_t* P; int ldc; const float* cosH; const float* sinH; const float* cosI; const float* sinI;
    __device__ __forceinline__ void operator()(const f32x4 (&acc)[2][2][4][2], const Unit& u, int wr, int wc, int fr, int fq) const {
        const int row0 = u.pm * BM + wr * 64 + fr;
#pragma unroll
        for (int bj = 0; bj < 2; ++bj) {
            const int c0 = u.pn * BM + bj * HALF + wc * 32 + 8 * fq;
            int type = 0, fo = 0;
            if (c0 < 2560 || (c0 >= 3072 && c0 < 5248)) { type = 1; fo = ((c0 & 127) >> 3) * 4; }
            else if (c0 >= 5376 && c0 < 6464) { type = 2; fo = ((c0 & 63) >> 3) * 4; }
#pragma unroll
            for (int ai = 0; ai < 2; ++ai)
#pragma unroll
                for (int m = 0; m < 4; ++m) { const int row = row0 + ai * HALF + m * 16;
                    f32x4 v0 = acc[ai][bj][m][0], v1 = acc[ai][bj][m][1];
                    if (type) { const float* ct = (type == 1) ? cosH + (size_t)row * 64 + fo : cosI + (size_t)row * 32 + fo;
                                const float* st = (type == 1) ? sinH + (size_t)row * 64 + fo : sinI + (size_t)row * 32 + fo;
                                const f32x4 cs = *(const f32x4*)ct, sn = *(const f32x4*)st;
                                const f32x4 lo = v0 * cs - v1 * sn, hi = v1 * cs + v0 * sn; v0 = lo; v1 = hi; }
                    u32x4 w; w.x = cvt_pk_bf16(v0[0], v0[1]); w.y = cvt_pk_bf16(v0[2], v0[3]); w.z = cvt_pk_bf16(v1[0], v1[1]); w.w = cvt_pk_bf16(v1[2], v1[3]);
                    *(u32x4*)(P + (size_t)row * ldc + c0) = w; }
        }
    }
};
struct EpiRes {
    static constexpr bool PERM = false, AFTER_DRAIN = false;
    const float* X; float* X1; int ldc; const float* modp; const float* bada; int chunk_off; int nada; int rows_per_batch_tile;
    __device__ __forceinline__ void operator()(const f32x4 (&acc)[2][2][4][2], const Unit& u, int wr, int wc, int fr, int fq) const {
        const int b = u.pm / rows_per_batch_tile;
        const int row0 = u.pm * BM + wr * 64 + fr;
#pragma unroll
        for (int bj = 0; bj < 2; ++bj)
#pragma unroll
            for (int n = 0; n < 2; ++n) { const int col = u.pn * BM + bj * HALF + wc * 32 + n * 16 + 4 * fq;
                f32x4 g = *(const f32x4*)(bada + chunk_off + col);
#pragma unroll
                for (int q = 0; q < 4; ++q) g += *(const f32x4*)(modp + (size_t)(q * 2 + b) * nada + chunk_off + col);
#pragma unroll
                for (int ai = 0; ai < 2; ++ai)
#pragma unroll
                    for (int m = 0; m < 4; ++m) { const size_t off = (size_t)(row0 + ai * HALF + m * 16) * ldc + col;
                        const f32x4 xv = *(const f32x4*)(X + off); *(f32x4*)(X1 + off) = xv + g * acc[ai][bj][m][n]; } }
    }
};

typedef int i32x4 __attribute__((ext_vector_type(4)));
struct EpiStoreBf16I8 {
    static constexpr bool PERM = true, AFTER_DRAIN = false;
    bf16_t* O; int ldc; const float* sa; const float* sb;
    __device__ __forceinline__ void operator()(const i32x4 (&acc)[2][2][4][2], const Unit& u, int wr, int wc, int fr, int fq) const {
        const int row0 = u.pm * BM + wr * 64 + fr, col0 = u.pn * BM + wc * 32 + 8 * fq;
        f32x4 sbv[2][2];
#pragma unroll
        for (int bj = 0; bj < 2; ++bj) { sbv[bj][0] = *(const f32x4*)(sb + col0 + bj * HALF); sbv[bj][1] = *(const f32x4*)(sb + col0 + bj * HALF + 4); }
#pragma unroll
        for (int ai = 0; ai < 2; ++ai)
#pragma unroll
            for (int m = 0; m < 4; ++m) { const int row = row0 + ai * HALF + m * 16; const float s = sa[row]; bf16_t* rowp = O + (size_t)row * ldc + col0;
#pragma unroll
                for (int bj = 0; bj < 2; ++bj) { const f32x4 v0 = __builtin_convertvector(acc[ai][bj][m][0], f32x4) * s * sbv[bj][0], v1 = __builtin_convertvector(acc[ai][bj][m][1], f32x4) * s * sbv[bj][1];
                    u32x4 w; w.x = cvt_pk_bf16(v0[0], v0[1]); w.y = cvt_pk_bf16(v0[2], v0[3]); w.z = cvt_pk_bf16(v1[0], v1[1]); w.w = cvt_pk_bf16(v1[2], v1[3]);
                    *(u32x4*)(rowp + bj * HALF) = w; } }
    }
};

struct EpiProjI8 {
    static constexpr bool PERM = true, AFTER_DRAIN = false;
    bf16_t* P; int ldc; const _Float16* ropeH; const _Float16* ropeI; const float* sa; const float* sb;
    __device__ __forceinline__ void operator()(const i32x4 (&acc)[2][2][4][2], const Unit& u, int wr, int wc, int fr, int fq) const {
        const int row0 = u.pm * BM + wr * 64 + fr;
#pragma unroll
        for (int bj = 0; bj < 2; ++bj) {
            const int c0 = u.pn * BM + bj * HALF + wc * 32 + 8 * fq;
            const f32x4 sb0 = *(const f32x4*)(sb + c0), sb1 = *(const f32x4*)(sb + c0 + 4);
            int type = 0, fo = 0;
            if (c0 < 2560 || (c0 >= 3072 && c0 < 5248)) { type = 1; fo = ((c0 & 127) >> 3) * 4; }
            else if (c0 >= 5376 && c0 < 6464) { type = 2; fo = ((c0 & 63) >> 3) * 4; }
#pragma unroll
            for (int ai = 0; ai < 2; ++ai)
#pragma unroll
                for (int m = 0; m < 4; ++m) { const int row = row0 + ai * HALF + m * 16; const float s = sa[row];
                    f32x4 v0 = __builtin_convertvector(acc[ai][bj][m][0], f32x4) * s * sb0, v1 = __builtin_convertvector(acc[ai][bj][m][1], f32x4) * s * sb1;
                    if (type) { typedef _Float16 h8 __attribute__((ext_vector_type(8)));
                                const h8 t8 = *(const h8*)((type == 1) ? ropeH + (size_t)row * 128 + 2 * fo : ropeI + (size_t)row * 64 + 2 * fo);
                                const f32x4 cs = {(float)t8[0], (float)t8[1], (float)t8[2], (float)t8[3]}, sn = {(float)t8[4], (float)t8[5], (float)t8[6], (float)t8[7]};
                                const f32x4 lo = v0 * cs - v1 * sn, hi = v1 * cs + v0 * sn; v0 = lo; v1 = hi; }
                    u32x4 w; w.x = cvt_pk_bf16(v0[0], v0[1]); w.y = cvt_pk_bf16(v0[2], v0[3]); w.z = cvt_pk_bf16(v1[0], v1[1]); w.w = cvt_pk_bf16(v1[2], v1[3]);
                    *(u32x4*)(P + (size_t)row * ldc + c0) = w; }
        }
    }
};

struct EpiResI8 {
    static constexpr bool PERM = true, AFTER_DRAIN = false;
    const float* X; bf16_t* X1; int ldc; const float* modp; const float* bada; int chunk_off; int nada; int rows_per_batch_tile; const float* sa; const float* sb;
    __device__ __forceinline__ void operator()(const i32x4 (&acc)[2][2][4][2], const Unit& u, int wr, int wc, int fr, int fq) const {
        const int b = u.pm / rows_per_batch_tile;
        const int row0 = u.pm * BM + wr * 64 + fr, col0 = u.pn * BM + wc * 32 + 8 * fq;
        f32x4 g[2][2];
#pragma unroll
        for (int bj = 0; bj < 2; ++bj)
#pragma unroll
            for (int n = 0; n < 2; ++n) { const int col = col0 + bj * HALF + 4 * n;
                g[bj][n] = *(const f32x4*)(modp + (size_t)b * nada + chunk_off + col) * *(const f32x4*)(sb + col); }
#pragma unroll
        for (int ai = 0; ai < 2; ++ai)
#pragma unroll
            for (int m = 0; m < 4; ++m) { const int row = row0 + ai * HALF + m * 16; const float s = sa[row];
#pragma unroll
                for (int bj = 0; bj < 2; ++bj) { const size_t off = (size_t)row * ldc + col0 + bj * HALF;
                    const f32x4 x0 = *(const f32x4*)(X + off), x1v = *(const f32x4*)(X + off + 4);
                    const f32x4 r0 = x0 + g[bj][0] * (__builtin_convertvector(acc[ai][bj][m][0], f32x4) * s), r1 = x1v + g[bj][1] * (__builtin_convertvector(acc[ai][bj][m][1], f32x4) * s);
                    u32x4 w; w.x = cvt_pk_bf16(r0[0], r0[1]); w.y = cvt_pk_bf16(r0[2], r0[3]); w.z = cvt_pk_bf16(r1[0], r1[1]); w.w = cvt_pk_bf16(r1[2], r1[3]);
                    *(u32x4*)(X1 + off) = w; } }
    }
};
template <class Epi, class Sched, bool ALIGN_EPI = false, bool SP2 = false>
__device__ __forceinline__ void gemm_phase(PG8_LAS unsigned char* lds, const Gemm g, const Sched& S, const Epi& E) {
    const int tid = threadIdx.x, wid = __builtin_amdgcn_readfirstlane(tid >> 6), lane = tid & 63, wr = wid >> 2, wc = wid & 3, fr = lane & 15, fq = lane >> 4;
    const int K = g.K, nt = K / BK;
    unsigned voffA[2], voffB[2];
#pragma unroll
    for (int i = 0; i < 2; ++i) { int R, C; stage_rc(tid * 16 + i * 8192, R, C); const int Rb = Epi::PERM ? ((R & ~31) + perm32(R & 31)) : R;
        voffA[i] = (unsigned)(R * K + C) * 2u; voffB[i] = (unsigned)(Rb * K + C) * 2u; }
    const size_t kstep = (size_t)(BK * 2);
    const size_t hstep = (size_t)HALF * K * 2;
    const size_t tstep = 2 * hstep;
    const unsigned ldsw = (unsigned)wid * 1024u;
    const int aoff = lds_byte(wr * 64 + fr, fq * 8), boff = lds_byte(wc * 32 + fr, fq * 8);
#define PG8_SA(b, h) (((b) * 2 + (h)) * HTB)
#define PG8_SB(b, h) ((4 + (b) * 2 + (h)) * HTB)
#define PG8_STAGE(bufoff, gbase, voff) do { _Pragma("unroll") for (int _i = 0; _i < 2; ++_i) \
        __builtin_amdgcn_global_load_lds((const unsigned*)((const char*)(gbase) + (voff)[_i]), (PG8_LAS unsigned*)(lds + (bufoff) + ldsw + _i * 8192), 16, 0, 0); } while (0)
#define PG8_LDA(dst, b, h) do { _Pragma("unroll") for (int m = 0; m < 4; ++m) _Pragma("unroll") for (int k = 0; k < 2; ++k) dst[m][k] = *(const PG8_LAS bf16x8*)(lds + PG8_SA(b, h) + aoff + m * 2048 + k * 1024); } while (0)
#define PG8_LDB(dst, b, h) do { _Pragma("unroll") for (int n = 0; n < 2; ++n) _Pragma("unroll") for (int k = 0; k < 2; ++k) dst[n][k] = *(const PG8_LAS bf16x8*)(lds + PG8_SB(b, h) + boff + n * 2048 + k * 1024); } while (0)
#define PG8_MMA(ai, bj, At, Bt) do { __builtin_amdgcn_s_setprio(1); _Pragma("unroll") for (int m = 0; m < 4; ++m) _Pragma("unroll") for (int n = 0; n < 2; ++n) _Pragma("unroll") for (int k = 0; k < 2; ++k) \
        acc[ai][bj][m][n] = __builtin_amdgcn_mfma_f32_16x16x32_bf16(Bt[n][k], At[m][k], acc[ai][bj][m][n], 0, 0, 0); __builtin_amdgcn_s_setprio(0); } while (0)
#define PG8_WAIT_V(n) asm volatile("s_waitcnt vmcnt(" #n ")" ::: "memory")
#define PG8_WAIT_L(n) asm volatile("s_waitcnt lgkmcnt(" #n ")" ::: "memory")
#define PG8_BAR __builtin_amdgcn_s_barrier()
#define PG8_SCHED __builtin_amdgcn_sched_barrier(0)
    Unit cur, nxt; int ui = 0;
    if (!S.next(0, cur)) return;
    f32x4 acc[2][2][4][2];
#pragma unroll
    for (int a = 0; a < 2; ++a)
#pragma unroll
        for (int b = 0; b < 2; ++b)
#pragma unroll
            for (int m = 0; m < 4; ++m)
#pragma unroll
                for (int n = 0; n < 2; ++n) acc[a][b][m][n] = (f32x4){0.f, 0.f, 0.f, 0.f};
    bf16x8 At[4][2], B0[2][2], B1[2][2];
    const char* cA = (const char*)g.A + (size_t)cur.pm * tstep; const char* cB = (const char*)g.Bt + (size_t)cur.pn * tstep;
    S.a_ready(cur);
    if constexpr (SP2) {
        PG8_STAGE(PG8_SB(0, 0), cB, voffB); PG8_STAGE(PG8_SB(0, 1), cB + hstep, voffB); PG8_STAGE(PG8_SA(0, 0), cA, voffA); PG8_STAGE(PG8_SA(0, 1), cA + hstep, voffA);
        if (wr == 1) PG8_BAR;
        PG8_WAIT_V(2); PG8_BAR;
        PG8_STAGE(PG8_SB(1, 0), cB + kstep, voffB); PG8_STAGE(PG8_SA(1, 0), cA + kstep, voffA); PG8_STAGE(PG8_SB(1, 1), cB + hstep + kstep, voffB);
        PG8_WAIT_V(6); PG8_BAR;
    } else {
        PG8_STAGE(PG8_SB(0, 0), cB, voffB); PG8_STAGE(PG8_SA(0, 0), cA, voffA); PG8_STAGE(PG8_SB(0, 1), cB + hstep, voffB); PG8_STAGE(PG8_SA(0, 1), cA + hstep, voffA);
        if (wr == 1) PG8_BAR;
        PG8_WAIT_V(4); PG8_BAR;
        PG8_STAGE(PG8_SB(1, 0), cB + kstep, voffB); PG8_STAGE(PG8_SA(1, 0), cA + kstep, voffA); PG8_STAGE(PG8_SB(1, 1), cB + hstep + kstep, voffB);
        PG8_WAIT_V(6); PG8_BAR;
    }
    for (;;) {
        const bool has_next = S.next(ui + 1, nxt);
        const char* nA = has_next ? (const char*)g.A + (size_t)nxt.pm * tstep : cA; const char* nB = has_next ? (const char*)g.Bt + (size_t)nxt.pn * tstep : cB;
        for (int t = 0; t < nt; t += 2) {
            const bool last = (t == nt - 2);
            const char* a1 = cA + (size_t)(t + 1) * kstep;
            const char* a2 = last ? nA : cA + (size_t)(t + 2) * kstep; const char* b2 = last ? nB : cB + (size_t)(t + 2) * kstep;
            const char* a3 = a2 + kstep; const char* b3 = b2 + kstep;
            if (last && has_next) S.a_ready(nxt);
            if constexpr (SP2) {
            PG8_LDB(B0, 0, 0); PG8_LDB(B1, 0, 1); PG8_SCHED; PG8_LDA(At, 0, 0); PG8_STAGE(PG8_SA(1, 1), a1 + hstep, voffA);
            PG8_WAIT_V(8); PG8_WAIT_L(0); PG8_BAR; PG8_MMA(0, 0, At, B0); PG8_MMA(0, 1, At, B1); PG8_BAR; PG8_SCHED;
            PG8_LDA(At, 0, 1); PG8_STAGE(PG8_SB(0, 0), b2, voffB); PG8_STAGE(PG8_SB(0, 1), b2 + hstep, voffB); PG8_STAGE(PG8_SA(0, 0), a2, voffA);
            PG8_WAIT_V(8); PG8_WAIT_L(0); PG8_BAR; PG8_MMA(1, 0, At, B0); PG8_MMA(1, 1, At, B1); PG8_BAR; PG8_SCHED;
            PG8_LDB(B0, 1, 0); PG8_LDB(B1, 1, 1); PG8_SCHED; PG8_LDA(At, 1, 0); PG8_STAGE(PG8_SA(0, 1), a2 + hstep, voffA);
            PG8_WAIT_V(8); PG8_WAIT_L(0); PG8_BAR; PG8_MMA(0, 0, At, B0); PG8_MMA(0, 1, At, B1); PG8_BAR; PG8_SCHED;
            PG8_LDA(At, 1, 1); PG8_STAGE(PG8_SB(1, 0), b3, voffB); PG8_STAGE(PG8_SB(1, 1), b3 + hstep, voffB); PG8_STAGE(PG8_SA(1, 0), a3, voffA);
            PG8_WAIT_V(8); PG8_WAIT_L(0); PG8_BAR; PG8_MMA(1, 0, At, B0); PG8_MMA(1, 1, At, B1); PG8_BAR; PG8_SCHED;
            } else {
            PG8_LDB(B0, 0, 0); PG8_SCHED; PG8_LDA(At, 0, 0); PG8_STAGE(PG8_SA(1, 1), a1 + hstep, voffA);
            PG8_WAIT_L(8); PG8_BAR; PG8_WAIT_L(0); PG8_MMA(0, 0, At, B0); PG8_BAR; PG8_SCHED;
            PG8_LDB(B1, 0, 1); PG8_STAGE(PG8_SB(0, 0), b2, voffB);
            PG8_BAR; PG8_WAIT_L(0); PG8_MMA(0, 1, At, B1); PG8_BAR;
            PG8_LDA(At, 0, 1); PG8_STAGE(PG8_SA(0, 0), a2, voffA);
            PG8_BAR; PG8_WAIT_L(0); PG8_MMA(1, 0, At, B0); PG8_BAR; PG8_SCHED;
            PG8_STAGE(PG8_SB(0, 1), b2 + hstep, voffB);
            PG8_WAIT_V(6); PG8_BAR; PG8_MMA(1, 1, At, B1); PG8_BAR;
            PG8_LDB(B0, 1, 0); PG8_SCHED; PG8_LDA(At, 1, 0); PG8_STAGE(PG8_SA(0, 1), a2 + hstep, voffA);
            PG8_WAIT_L(8); PG8_BAR; PG8_WAIT_L(0); PG8_MMA(0, 0, At, B0); PG8_BAR; PG8_SCHED;
            PG8_LDB(B1, 1, 1); PG8_STAGE(PG8_SB(1, 0), b3, voffB);
            PG8_BAR; PG8_WAIT_L(0); PG8_MMA(0, 1, At, B1); PG8_BAR;
            PG8_LDA(At, 1, 1); PG8_STAGE(PG8_SA(1, 0), a3, voffA);
            PG8_BAR; PG8_WAIT_L(0); PG8_MMA(1, 0, At, B0); PG8_BAR; PG8_SCHED;
            PG8_STAGE(PG8_SB(1, 1), b3 + hstep, voffB);
            PG8_WAIT_V(6); PG8_BAR; PG8_MMA(1, 1, At, B1); PG8_BAR;
            }
        }
        if constexpr (ALIGN_EPI) { if (wr == 0) PG8_BAR; }
        if constexpr (!Epi::AFTER_DRAIN) { E(acc, cur, wr, wc, fr, fq); S.done(cur); }
        if (!has_next) break;
#pragma unroll
        for (int a = 0; a < 2; ++a)
#pragma unroll
            for (int b = 0; b < 2; ++b)
#pragma unroll
                for (int m = 0; m < 4; ++m)
#pragma unroll
                    for (int n = 0; n < 2; ++n) acc[a][b][m][n] = (f32x4){0.f, 0.f, 0.f, 0.f};
        cur = nxt; cA = nA; cB = nB; ++ui;
        if constexpr (ALIGN_EPI) { if (wr == 1) PG8_BAR; }
    }
    PG8_WAIT_V(0);
    if constexpr (!ALIGN_EPI) { if (wr == 0) PG8_BAR; }
    PG8_BAR;
    if constexpr (Epi::AFTER_DRAIN) { E.fused(acc, cur, wr, wc, fr, fq, lds, wid, lane); S.done(cur); }
#undef PG8_SA
#undef PG8_SB
#undef PG8_STAGE
#undef PG8_LDA
#undef PG8_LDB
#undef PG8_MMA
#undef PG8_WAIT_V
#undef PG8_WAIT_L
#undef PG8_BAR
#undef PG8_SCHED
}

typedef int i32x4 __attribute__((ext_vector_type(4)));
template <class Epi, class Sched, bool ALIGN_EPI = false, bool SP2 = false>
__device__ __forceinline__ void gemm_phase_i8(PG8_LAS unsigned char* lds, const Gemm g, const Sched& S, const Epi& E) {
    const int tid = threadIdx.x, wid = __builtin_amdgcn_readfirstlane(tid >> 6), lane = tid & 63, wr = wid >> 2, wc = wid & 3, fr = lane & 15, fq = lane >> 4;
    const int K = g.K, nt = K / BK;
    unsigned voffA[2], voffB[2];
#pragma unroll
    for (int i = 0; i < 2; ++i) { int R, C; stage_rc(tid * 16 + i * 8192, R, C); const int Rb = Epi::PERM ? ((R & ~31) + perm32(R & 31)) : R;
        voffA[i] = (unsigned)(R * K + C) * 2u; voffB[i] = (unsigned)(Rb * K + C) * 2u; }
    const size_t kstep = (size_t)(BK * 2);
    const size_t hstep = (size_t)HALF * K * 2;
    const size_t tstep = 2 * hstep;
    const unsigned ldsw = (unsigned)wid * 1024u;
    const int aoff = lds_byte(wr * 64 + fr, fq * 8), boff = lds_byte(wc * 32 + fr, fq * 8);
#define PG8_SA(b, h) (((b) * 2 + (h)) * HTB)
#define PG8_SB(b, h) ((4 + (b) * 2 + (h)) * HTB)
#define PG8_STAGE(bufoff, gbase, voff) do { _Pragma("unroll") for (int _i = 0; _i < 2; ++_i) \
        __builtin_amdgcn_global_load_lds((const unsigned*)((const char*)(gbase) + (voff)[_i]), (PG8_LAS unsigned*)(lds + (bufoff) + ldsw + _i * 8192), 16, 0, 0); } while (0)
#define PG8_LDA(dst, b, h) do { _Pragma("unroll") for (int m = 0; m < 4; ++m) _Pragma("unroll") for (int k = 0; k < 2; ++k) dst[m][k] = *(const PG8_LAS i32x4*)(lds + PG8_SA(b, h) + aoff + m * 2048 + k * 1024); } while (0)
#define PG8_LDB(dst, b, h) do { _Pragma("unroll") for (int n = 0; n < 2; ++n) _Pragma("unroll") for (int k = 0; k < 2; ++k) dst[n][k] = *(const PG8_LAS i32x4*)(lds + PG8_SB(b, h) + boff + n * 2048 + k * 1024); } while (0)
#define PG8_MMA(ai, bj, At, Bt) do { __builtin_amdgcn_s_setprio(1); _Pragma("unroll") for (int m = 0; m < 4; ++m) _Pragma("unroll") for (int n = 0; n < 2; ++n) _Pragma("unroll") for (int k = 0; k < 2; ++k) \
        acc[ai][bj][m][n] = __builtin_amdgcn_mfma_i32_16x16x64_i8(Bt[n][k], At[m][k], acc[ai][bj][m][n], 0, 0, 0); __builtin_amdgcn_s_setprio(0); } while (0)
#define PG8_WAIT_V(n) asm volatile("s_waitcnt vmcnt(" #n ")" ::: "memory")
#define PG8_WAIT_L(n) asm volatile("s_waitcnt lgkmcnt(" #n ")" ::: "memory")
#define PG8_BAR __builtin_amdgcn_s_barrier()
#define PG8_SCHED __builtin_amdgcn_sched_barrier(0)
    Unit cur, nxt; int ui = 0;
    if (!S.next(0, cur)) return;
    i32x4 acc[2][2][4][2];
#pragma unroll
    for (int a = 0; a < 2; ++a)
#pragma unroll
        for (int b = 0; b < 2; ++b)
#pragma unroll
            for (int m = 0; m < 4; ++m)
#pragma unroll
                for (int n = 0; n < 2; ++n) acc[a][b][m][n] = (i32x4){0, 0, 0, 0};
    i32x4 At[4][2], B0[2][2], B1[2][2];
    const char* cA = (const char*)g.A + (size_t)cur.pm * tstep; const char* cB = (const char*)g.Bt + (size_t)cur.pn * tstep;
    S.a_ready(cur);
    if constexpr (SP2) {
        PG8_STAGE(PG8_SB(0, 0), cB, voffB); PG8_STAGE(PG8_SB(0, 1), cB + hstep, voffB); PG8_STAGE(PG8_SA(0, 0), cA, voffA); PG8_STAGE(PG8_SA(0, 1), cA + hstep, voffA);
        if (wr == 1) PG8_BAR;
        PG8_WAIT_V(2); PG8_BAR;
        PG8_STAGE(PG8_SB(1, 0), cB + kstep, voffB); PG8_STAGE(PG8_SA(1, 0), cA + kstep, voffA); PG8_STAGE(PG8_SB(1, 1), cB + hstep + kstep, voffB);
        PG8_WAIT_V(6); PG8_BAR;
    } else {
        PG8_STAGE(PG8_SB(0, 0), cB, voffB); PG8_STAGE(PG8_SA(0, 0), cA, voffA); PG8_STAGE(PG8_SB(0, 1), cB + hstep, voffB); PG8_STAGE(PG8_SA(0, 1), cA + hstep, voffA);
        if (wr == 1) PG8_BAR;
        PG8_WAIT_V(4); PG8_BAR;
        PG8_STAGE(PG8_SB(1, 0), cB + kstep, voffB); PG8_STAGE(PG8_SA(1, 0), cA + kstep, voffA); PG8_STAGE(PG8_SB(1, 1), cB + hstep + kstep, voffB);
        PG8_WAIT_V(6); PG8_BAR;
    }
    for (;;) {
        const bool has_next = S.next(ui + 1, nxt);
        const char* nA = has_next ? (const char*)g.A + (size_t)nxt.pm * tstep : cA; const char* nB = has_next ? (const char*)g.Bt + (size_t)nxt.pn * tstep : cB;
        for (int t = 0; t < nt; t += 2) {
            const bool last = (t == nt - 2);
            const char* a1 = cA + (size_t)(t + 1) * kstep;
            const char* a2 = last ? nA : cA + (size_t)(t + 2) * kstep; const char* b2 = last ? nB : cB + (size_t)(t + 2) * kstep;
            const char* a3 = a2 + kstep; const char* b3 = b2 + kstep;
            if (last && has_next) S.a_ready(nxt);
            if constexpr (SP2) {
            PG8_LDB(B0, 0, 0); PG8_LDB(B1, 0, 1); PG8_SCHED; PG8_LDA(At, 0, 0); PG8_STAGE(PG8_SA(1, 1), a1 + hstep, voffA);
            PG8_WAIT_V(8); PG8_WAIT_L(0); PG8_BAR; PG8_MMA(0, 0, At, B0); PG8_MMA(0, 1, At, B1); PG8_BAR; PG8_SCHED;
            PG8_LDA(At, 0, 1); PG8_STAGE(PG8_SB(0, 0), b2, voffB); PG8_STAGE(PG8_SB(0, 1), b2 + hstep, voffB); PG8_STAGE(PG8_SA(0, 0), a2, voffA);
            PG8_WAIT_V(8); PG8_WAIT_L(0); PG8_BAR; PG8_MMA(1, 0, At, B0); PG8_MMA(1, 1, At, B1); PG8_BAR; PG8_SCHED;
            PG8_LDB(B0, 1, 0); PG8_LDB(B1, 1, 1); PG8_SCHED; PG8_LDA(At, 1, 0); PG8_STAGE(PG8_SA(0, 1), a2 + hstep, voffA);
            PG8_WAIT_V(8); PG8_WAIT_L(0); PG8_BAR; PG8_MMA(0, 0, At, B0); PG8_MMA(0, 1, At, B1); PG8_BAR; PG8_SCHED;
            PG8_LDA(At, 1, 1); PG8_STAGE(PG8_SB(1, 0), b3, voffB); PG8_STAGE(PG8_SB(1, 1), b3 + hstep, voffB); PG8_STAGE(PG8_SA(1, 0), a3, voffA);
            PG8_WAIT_V(8); PG8_WAIT_L(0); PG8_BAR; PG8_MMA(1, 0, At, B0); PG8_MMA(1, 1, At, B1); PG8_BAR; PG8_SCHED;
            } else {
            PG8_LDB(B0, 0, 0); PG8_SCHED; PG8_LDA(At, 0, 0); PG8_STAGE(PG8_SA(1, 1), a1 + hstep, voffA);
            PG8_WAIT_L(8); PG8_BAR; PG8_WAIT_L(0); PG8_MMA(0, 0, At, B0); PG8_BAR; PG8_SCHED;
            PG8_LDB(B1, 0, 1); PG8_STAGE(PG8_SB(0, 0), b2, voffB);
            PG8_BAR; PG8_WAIT_L(0); PG8_MMA(0, 1, At, B1); PG8_BAR;
            PG8_LDA(At, 0, 1); PG8_STAGE(PG8_SA(0, 0), a2, voffA);
            PG8_BAR; PG8_WAIT_L(0); PG8_MMA(1, 0, At, B0); PG8_BAR; PG8_SCHED;
            PG8_STAGE(PG8_SB(0, 1), b2 + hstep, voffB);
            PG8_WAIT_V(6); PG8_BAR; PG8_MMA(1, 1, At, B1); PG8_BAR;
            PG8_LDB(B0, 1, 0); PG8_SCHED; PG8_LDA(At, 1, 0); PG8_STAGE(PG8_SA(0, 1), a2 + hstep, voffA);
            PG8_WAIT_L(8); PG8_BAR; PG8_WAIT_L(0); PG8_MMA(0, 0, At, B0); PG8_BAR; PG8_SCHED;
            PG8_LDB(B1, 1, 1); PG8_STAGE(PG8_SB(1, 0), b3, voffB);
            PG8_BAR; PG8_WAIT_L(0); PG8_MMA(0, 1, At, B1); PG8_BAR;
            PG8_LDA(At, 1, 1); PG8_STAGE(PG8_SA(1, 0), a3, voffA);
            PG8_BAR; PG8_WAIT_L(0); PG8_MMA(1, 0, At, B0); PG8_BAR; PG8_SCHED;
            PG8_STAGE(PG8_SB(1, 1), b3 + hstep, voffB);
            PG8_WAIT_V(6); PG8_BAR; PG8_MMA(1, 1, At, B1); PG8_BAR;
            }
        }
        if constexpr (ALIGN_EPI) { if (wr == 0) PG8_BAR; }
        if constexpr (!Epi::AFTER_DRAIN) { E(acc, cur, wr, wc, fr, fq); S.done(cur); }
        if (!has_next) break;
#pragma unroll
        for (int a = 0; a < 2; ++a)
#pragma unroll
            for (int b = 0; b < 2; ++b)
#pragma unroll
                for (int m = 0; m < 4; ++m)
#pragma unroll
                    for (int n = 0; n < 2; ++n) acc[a][b][m][n] = (i32x4){0, 0, 0, 0};
        cur = nxt; cA = nA; cB = nB; ++ui;
        if constexpr (ALIGN_EPI) { if (wr == 1) PG8_BAR; }
    }
    PG8_WAIT_V(0);
    if constexpr (!ALIGN_EPI) { if (wr == 0) PG8_BAR; }
    PG8_BAR;
    if constexpr (Epi::AFTER_DRAIN) { E.fused(acc, cur, wr, wc, fr, fq, lds, wid, lane); S.done(cur); }
#undef PG8_SA
#undef PG8_SB
#undef PG8_STAGE
#undef PG8_LDA
#undef PG8_LDB
#undef PG8_MMA
#undef PG8_WAIT_V
#undef PG8_WAIT_L
#undef PG8_BAR
#undef PG8_SCHED
}
}
constexpr int NWAVES = 8;
constexpr int NB = 2, SEQ = 4096, DM = 4096, NTOK = NB * SEQ;
constexpr int NPROJ = 6480, PROJ_LD = 6656;
constexpr int C_QA = 0, C_KA = 2048, C_VA = 2560, C_QB = 3072, C_KB = 5120, C_VB = 5248, C_QI = 5376, C_KI = 6400, C_WI = 6464;
constexpr int NADA = 6 * DM;
constexpr int NEXP = 16384, PQ_LD = 2048;
constexpr float NORM_EPS = 1e-6f;
#ifndef DBG_NOPEER
#define DBG_NOPEER 0
#endif
#ifndef DSA_TR
#define DSA_TR 0
#endif
#ifndef DBG_DSA
#define DBG_DSA 1
#endif
#ifndef MIX_ENABLE
#define MIX_ENABLE 1
#endif
constexpr size_t MiB = 1u << 20;
constexpr size_t WS_CTL = 0, CTL_ZERO_BYTES = 64 * 1024;
constexpr size_t WS_MODP = 1 * MiB;
constexpr size_t WS_COSH = 2 * MiB, WS_SINH = 4 * MiB, WS_COSI = 6 * MiB, WS_SINI = 7 * MiB;
constexpr size_t WS_SK = 8 * MiB;
constexpr size_t WS_USC = 20 * MiB;
constexpr size_t WS_LSE = 18 * MiB;
constexpr size_t WS_WIN = 32 * MiB;
constexpr size_t WS_WOUT = 84 * MiB;
constexpr size_t WS_WQ = 116 * MiB;
constexpr size_t WS_H = 132 * MiB;
constexpr size_t WS_PROJ = 196 * MiB;
constexpr size_t WS_SCORE = 300 * MiB;
constexpr size_t WS_OAP = 428 * MiB;
constexpr size_t WS_O = 524 * MiB;
constexpr size_t WS_X1 = 588 * MiB;
constexpr size_t WS_PQ = 716 * MiB;
constexpr int PV_ROW = 2048;
constexpr size_t WS_U16 = 748 * MiB;
constexpr size_t WS_V16 = 876 * MiB;
constexpr size_t WS_H8 = 940 * MiB;
constexpr size_t WS_WQ8 = 972 * MiB;
constexpr size_t WS_WIN8 = 980 * MiB;
constexpr size_t WS_WOUT8 = 1008 * MiB;
constexpr size_t WS_SAO = 24 * MiB, WS_SBO = 25 * MiB;
constexpr size_t WS_SBIN = 23 * MiB;
constexpr size_t WS_SAH = 21 * MiB, WS_SBQ = 22 * MiB;
constexpr size_t WS_END = 1024 * MiB;
constexpr int CW_BAR = 4096;
constexpr int RING_OFF = 0, RING_BYTES = 131072;
constexpr int LDS_BYTES = 163840;
constexpr int LDSCTL_OFF = LDS_BYTES - 1024, MISC_OFF = LDSCTL_OFF + 320;
#define GAS __attribute__((address_space(1)))
#define LAS __attribute__((address_space(3)))
typedef unsigned short bf16;
typedef unsigned v4u __attribute__((ext_vector_type(4)));
typedef float f32x4 __attribute__((ext_vector_type(4)));
typedef short bf16x8 __attribute__((ext_vector_type(8)));
typedef GAS unsigned gu32;
typedef GAS unsigned long long gu64;
#define RLX_AGENT __ATOMIC_RELAXED, __HIP_MEMORY_SCOPE_AGENT
#define LDS_WAIT() asm volatile("s_waitcnt lgkmcnt(0)" ::: "memory")
#define VM_WAIT() asm volatile("s_waitcnt vmcnt(0)" ::: "memory")
__device__ __forceinline__ unsigned long long rt() { return __builtin_amdgcn_s_memrealtime(); }
__device__ __forceinline__ unsigned f2bf(float f) { unsigned u = __builtin_bit_cast(unsigned, f); return (u + 0x7fffu + ((u >> 16) & 1u)) >> 16; }
__device__ __forceinline__ unsigned pk2(float lo, float hi) { return f2bf(lo) | (f2bf(hi) << 16); }

#define XB_TMO      128
#define XB_XCNT(j)  (256  + 64 * (j))
#define XB_XSUB(j)  (1280 + 64 * (j))
#define XB_XGEN(j)  (2304 + 64 * (j))
#define XB_TOP      3328
#define XB_TOPGEN   3392
#define XCD_BAR_WORDS 3456
#define XB_SPIN_CAP (1u << 18)

__device__ __forceinline__ unsigned xb_ld(unsigned* p)              { return __hip_atomic_load(p, __ATOMIC_RELAXED, __HIP_MEMORY_SCOPE_AGENT); }
__device__ __forceinline__ unsigned xb_add(unsigned* p, unsigned v) { return __hip_atomic_fetch_add(p, v, __ATOMIC_RELAXED, __HIP_MEMORY_SCOPE_AGENT); }
__device__ __forceinline__ unsigned xb_xcc_id() { return (unsigned)__builtin_amdgcn_s_getreg((3 << 11) | 20) & 0xFu; }
#define XB_SPIN(cond, bar) do { unsigned _sp = 0; while (cond) { __builtin_amdgcn_s_sleep(1); \
    if ((++_sp & 255u) == 0u) { if (xb_ld(&(bar)[XB_TMO])) break; if (_sp > XB_SPIN_CAP) { atomicAdd(&(bar)[XB_TMO], 1u); break; } } } } while (0)

struct XcdBarrier {
    unsigned* bar; unsigned x;
    volatile LAS unsigned* st;
};

__device__ __forceinline__ XcdBarrier xcd_barrier_post(unsigned* bar, volatile LAS unsigned* st) {
    XcdBarrier b; b.bar = bar; b.x = xb_xcc_id(); b.st = st;
    if (threadIdx.x == 0) (void)xb_add(&bar[XB_XCNT(b.x)], 1u);
    return b;
}
__device__ __forceinline__ void xcd_barrier_complete(unsigned* bar, unsigned x, unsigned& nloc, unsigned& nx) {
    const unsigned G = gridDim.x * gridDim.y * gridDim.z;
    unsigned sum, cnt, mine, sp = 0u;
    for (;;) {
        sum = 0u; cnt = 0u; mine = 0u;
#pragma unroll
        for (unsigned j = 0; j < 16; ++j) { const unsigned c = xb_ld(&bar[XB_XCNT(j)]); sum += c; cnt += (c > 0u) ? 1u : 0u; mine = (j == x) ? c : mine; }
        if (sum == G) break;
        __builtin_amdgcn_s_sleep(1);
        if ((++sp & 255u) == 0u) { if (xb_ld(&bar[XB_TMO])) break; if (sp > XB_SPIN_CAP) { atomicAdd(&bar[XB_TMO], 1u); break; } }
    }
    nloc = mine > 0u ? mine : 1u; nx = cnt > 0u ? cnt : 1u;
}

__device__ __forceinline__ void xcd_barrier(const XcdBarrier& b) {
    asm volatile("s_waitcnt vmcnt(0)" ::: "memory");
    __syncthreads();
    if (threadIdx.x == 0) {
        unsigned* bar = b.bar;
        __builtin_amdgcn_s_waitcnt(0);
        unsigned nloc = b.st[0], nx = b.st[1];
        if (nloc == 0u) { xcd_barrier_complete(bar, b.x, nloc, nx); b.st[0] = nloc; b.st[1] = nx; }
        const unsigned old = xb_add(&bar[XB_XSUB(b.x)], 1u);
        const unsigned gen = old / nloc;
        if (old + 1u == (gen + 1u) * nloc) {
            __builtin_amdgcn_fence(__ATOMIC_RELEASE, "agent");
            asm volatile("s_waitcnt vmcnt(0)" ::: "memory");
            const unsigned og = xb_add(&bar[XB_TOP], 1u);
            const unsigned tg = og / nx;
            if (og + 1u == (tg + 1u) * nx) xb_add(&bar[XB_TOPGEN], 1u);
            else XB_SPIN(xb_ld(&bar[XB_TOPGEN]) == tg, bar);
            __builtin_amdgcn_fence(__ATOMIC_ACQUIRE, "agent");
            xb_add(&bar[XB_XGEN(b.x)], 1u);
            asm volatile("s_waitcnt vmcnt(0)" ::: "memory");
        } else {
            XB_SPIN(xb_ld(&bar[XB_XGEN(b.x)]) == gen, bar);
            __builtin_amdgcn_fence(__ATOMIC_ACQUIRE, "agent");
            asm volatile("s_waitcnt vmcnt(0)" ::: "memory");
        }
    }
    __syncthreads();
}

typedef short s16x4 __attribute__((ext_vector_type(4)));
typedef float f32x16 __attribute__((ext_vector_type(16)));
typedef float f32x2v __attribute__((ext_vector_type(2)));
typedef short v4i16_t __attribute__((ext_vector_type(4)));
#define MFMA16(a, b, c) __builtin_amdgcn_mfma_f32_16x16x32_bf16((a), (b), (c), 0, 0, 0)
#define MFMA32(a, b, c) __builtin_amdgcn_mfma_f32_32x32x16_bf16((a), (b), (c), 0, 0, 0)
#define CBAR() asm volatile("" ::: "memory")
__device__ __forceinline__ s16x4 vtr(const LAS unsigned char* p) { return __builtin_bit_cast(s16x4, __builtin_amdgcn_ds_read_tr16_b64_v4i16((LAS v4i16_t*)p)); }
__device__ __forceinline__ float bf_lo(unsigned w) { return __uint_as_float(w << 16); }
__device__ __forceinline__ float bf_hi(unsigned w) { return __uint_as_float(w & 0xffff0000u); }
__device__ __forceinline__ unsigned cvtpk(float lo, float hi) { unsigned r; asm volatile("v_cvt_pk_bf16_f32 %0, %1, %2" : "=v"(r) : "v"(lo), "v"(hi)); return r; }
__device__ __forceinline__ float wave_sum(float v) {
#pragma unroll
    for (int o = 1; o < 64; o <<= 1) v += __shfl_xor(v, o);
    return v;
}
__device__ __forceinline__ float fexp2(float x) { return __builtin_amdgcn_exp2f(x); }
__device__ __forceinline__ int wave_sum_i(int v) {
    v += __builtin_amdgcn_update_dpp(0, v, 0xB1, 0xF, 0xF, true);
    v += __builtin_amdgcn_update_dpp(0, v, 0x4E, 0xF, 0xF, true);
    v += __builtin_amdgcn_update_dpp(0, v, 0x141, 0xF, 0xF, true);
    v += __builtin_amdgcn_update_dpp(0, v, 0x140, 0xF, 0xF, true);
    v += __builtin_amdgcn_update_dpp(0, v, 0x142, 0xA, 0xF, true);
    v += __builtin_amdgcn_update_dpp(0, v, 0x143, 0xC, 0xF, true);
    return __builtin_amdgcn_readlane(v, 63);
}

struct Frame {
    LAS unsigned char* lds;
    volatile LAS unsigned* MISC;
    gu32* ctl;
    int tid, lane, wave, G;
    const float *x, *c; const int* pos; const float *ln1g, *ln2g, *w_ada, *b_ada, *w_in, *w_out, *wq, *subk, *pu, *pv, *lnfg;
    float* out;
    float *modp, *lse, *score; _Float16 *ropeH, *ropeI; bf16* x1;
    bf16 *sk, *win, *wout, *wqt, *h, *proj, *oap, *o, *pq; unsigned char *u8, *v8; float* usc; signed char *h8, *wq8, *win8, *o8, *wout8; float *sah, *sbq, *sbin, *sao, *sbo; int* reg; float* rgg;
};

__device__ __forceinline__ float silu_f(float v) { return v / (1.f + expf(-v)); }
__device__ __forceinline__ void p0_gemv(Frame& F) {
    LAS float* sl = (LAS float*)(F.lds);
    LAS float* red = (LAS float*)(F.lds + 32768);
    if ((int)blockIdx.x >= 192) return;
    int tid = F.tid; asm volatile("" : "+v"(tid));
    for (int i = tid; i < 2 * DM; i += NWAVES * 64) sl[i] = silu_f(F.c[i]);
    __syncthreads();
    for (int cg = blockIdx.x; cg < 192; cg += F.G) {
        const int half = F.lane >> 5, c4 = (F.lane & 31) * 4, k0 = F.wave * 512;
        const float* wp = F.w_ada + (size_t)(k0 + half) * NADA + cg * 128 + c4;
        f32x4 a0 = (f32x4){0.f, 0.f, 0.f, 0.f}, a1 = a0;
#pragma unroll 16
        for (int k = 0; k < 256; ++k) { const f32x4 w = __builtin_nontemporal_load((const f32x4*)(wp + (size_t)(2 * k) * NADA)); const float s0 = sl[k0 + 2 * k + half], s1 = sl[DM + k0 + 2 * k + half];
            a0 += w * s0; a1 += w * s1; }
#pragma unroll
        for (int e = 0; e < 4; ++e) { a0[e] += __shfl_xor(a0[e], 32); a1[e] += __shfl_xor(a1[e], 32); }
        if (half == 0) { *(LAS f32x4*)(red + (F.wave * 2 + 0) * 128 + c4) = a0; *(LAS f32x4*)(red + (F.wave * 2 + 1) * 128 + c4) = a1; }
        __syncthreads();
        if (F.tid < 256) { const int b = F.tid >> 7, cc = F.tid & 127; float s = F.b_ada[cg * 128 + cc];
#pragma unroll
            for (int w = 0; w < 8; ++w) s += red[(w * 2 + b) * 128 + cc];
            F.modp[(size_t)b * NADA + cg * 128 + cc] = s; }
        __syncthreads();
    }
}
__device__ __forceinline__ int proj_orig_col(int c) {
    if (c >= NPROJ) return -1;
    int base, w, half;
    if (c < 2560 || (c >= 3072 && c < 5248)) { base = c & ~127; w = c & 127; half = 64; }
    else if (c >= 5376 && c < 6464) { base = c & ~63; w = c & 63; half = 32; }
    else return c;
    const int i = w >> 3, j = w & 7;
    return base + ((j < 4) ? 4 * i + j : half + 4 * i + (j - 4));
}
template <bool PERMUTE>
__device__ __forceinline__ void p0_transpose_item(const float* W, int K, int N, int Nout, bf16* WT, LAS float* scr, int item, int lane) {
    const int nblk = Nout / 64, kb = item / nblk, nb = item % nblk, k0 = 64 * kb, n0 = 64 * nb;
    const int q = lane & 15, kr = lane >> 4;
    const int srcc = PERMUTE ? proj_orig_col(n0 + 4 * q) : n0 + 4 * q;
#pragma unroll 8
    for (int i = 0; i < 16; ++i) { const int kk = 4 * i + kr; f32x4 v = (f32x4){0.f, 0.f, 0.f, 0.f}; if (srcc >= 0) v = *(const f32x4*)(W + (size_t)(k0 + kk) * N + srcc);
        LAS float* d = scr + kk * 65 + 4 * q; d[0] = v.x; d[1] = v.y; d[2] = v.z; d[3] = v.w; }
    LDS_WAIT(); CBAR();
    const int c = lane & 7;
#pragma unroll
    for (int j = 0; j < 8; ++j) { const int n = (lane >> 3) + 8 * j; const LAS float* sp = scr + (8 * c) * 65 + n;
        v4u o; o.x = pk2(sp[0 * 65], sp[1 * 65]); o.y = pk2(sp[2 * 65], sp[3 * 65]); o.z = pk2(sp[4 * 65], sp[5 * 65]); o.w = pk2(sp[6 * 65], sp[7 * 65]);
        *(GAS v4u*)(WT + (size_t)(n0 + n) * K + k0 + 8 * c) = o; }
    LDS_WAIT(); CBAR();
}
__device__ __forceinline__ void sincos_d(double a, float& sn, float& cs) {
    const double q = rint(a * 0.63661977236758134308);
    double r = fma(-q, 1.57079632679489655800, a); r = fma(-q, 6.12323399573676603587e-17, r);
    const int qi = ((int)q) & 3; const double r2 = r * r;
    double sp = -1.0 / 39916800.0; sp = fma(sp, r2, 1.0 / 362880.0); sp = fma(sp, r2, -1.0 / 5040.0); sp = fma(sp, r2, 1.0 / 120.0); sp = fma(sp, r2, -1.0 / 6.0); sp = fma(sp * r2, r, r);
    double cp = 1.0 / 479001600.0; cp = fma(cp, r2, -1.0 / 3628800.0); cp = fma(cp, r2, 1.0 / 40320.0); cp = fma(cp, r2, -1.0 / 720.0); cp = fma(cp, r2, 1.0 / 24.0); cp = fma(cp, r2, -0.5); cp = fma(cp, r2, 1.0);
    const double s = (qi & 1) ? cp : sp, c = (qi & 1) ? sp : cp;
    sn = (float)((qi & 2) ? -s : s); cs = (float)(((qi + 1) & 2) ? -c : c);
}
constexpr int I_WIN = (DM / 64) * (PROJ_LD / 64), I_WOUT = (DM / 64) * (DM / 64), I_WQ = (DM / 64) * (PQ_LD / 64), I_SK = 256, I_ROPE = NTOK, I_UV = 2 * NEXP;
constexpr int NITEMS_A = I_WIN + I_SK + I_ROPE, NITEMS_B = I_UV + I_WOUT + I_WQ;
constexpr int ROWS_IN_P4 = 16384, ROWS4_PER_TOK = 2; static_assert(ROWS_IN_P4 == NEXP, "P4 converts exactly the v table");
__device__ __forceinline__ void conv_item_a(Frame& F, int r, LAS float* scr) {
    const int lane = F.lane;
    if (r < I_WIN) { p0_transpose_item<true>(F.w_in, DM, NPROJ, PROJ_LD, F.win, scr, r, lane); return; } r -= I_WIN;
    if (r < I_SK) { const float* src = F.subk + (size_t)r * 1024; bf16* dst = F.sk + (size_t)r * 1024;
#pragma unroll
        for (int j = 0; j < 4; ++j) { const f32x4 v = *(const f32x4*)(src + j * 256 + lane * 4); unsigned long long o = (unsigned long long)pk2(v.x, v.y) | ((unsigned long long)pk2(v.z, v.w) << 32);
            *(GAS unsigned long long*)(dst + j * 256 + lane * 4) = o; }
        return; } r -= I_SK;
    {
        const double p = (double)F.pos[r];
        const double LOG2_THETA = 13.287712379549449;
        { const double inv = exp2(-(double)lane * (1.0 / 64.0) * LOG2_THETA); float sn, cs; sincos_d(p * inv, sn, cs); _Float16* tp = F.ropeH + (size_t)r * 128 + (lane >> 2) * 8 + (lane & 3); tp[0] = (_Float16)cs; tp[4] = (_Float16)sn; }
        if (lane < 32) { const double inv = exp2(-(double)lane * (1.0 / 32.0) * LOG2_THETA); float sn, cs; sincos_d(p * inv, sn, cs); _Float16* tp = F.ropeI + (size_t)r * 64 + (lane >> 2) * 8 + (lane & 3); tp[0] = (_Float16)cs; tp[4] = (_Float16)sn; }
    }
}
__device__ __forceinline__ void conv_item_b(Frame& F, int r, LAS float* scr) {
    const int lane = F.lane;
    if (r < NEXP) {
        const float* src = F.pu + (size_t)r * DM; unsigned char* dst = F.u8 + (size_t)r * (DM / 2);
        const int kb = 128 * (lane >> 4) + 16 * ((lane >> 2) & 3) + 4 * (lane & 3);
        f32x4 lo[8], hi[8]; float ss = 0.f;
#pragma unroll
        for (int t = 0; t < 8; ++t) { lo[t] = __builtin_nontemporal_load((const f32x4*)(src + 512 * t + kb)); hi[t] = __builtin_nontemporal_load((const f32x4*)(src + 512 * t + kb + 64));
            ss += (lo[t].x * lo[t].x + lo[t].y * lo[t].y) + (lo[t].z * lo[t].z + lo[t].w * lo[t].w) + (hi[t].x * hi[t].x + hi[t].y * hi[t].y) + (hi[t].z * hi[t].z + hi[t].w * hi[t].w); }
        ss = wave_sum(ss);
        const float step = ss > 0.f ? 0.3352f * sqrtf(ss * (1.f / DM)) : 1.f, inv = 1.f / step;
        if (lane == 0) F.usc[r] = step;
#pragma unroll
        for (int t = 0; t < 8; ++t) { const float fl[4] = {lo[t].x, lo[t].y, lo[t].z, lo[t].w}, fh[4] = {hi[t].x, hi[t].y, hi[t].z, hi[t].w}; unsigned w = 0u;
#pragma unroll
            for (int i = 0; i < 4; ++i) { int ql = (int)floorf(fl[i] * inv) + 8, qh = (int)floorf(fh[i] * inv) + 8; ql = ql < 0 ? 0 : (ql > 15 ? 15 : ql); qh = qh < 0 ? 0 : (qh > 15 ? 15 : qh);
                w |= ((unsigned)ql | ((unsigned)qh << 4)) << (8 * i); }
            *(GAS unsigned*)(dst + 256 * t + 4 * lane) = w; }
        return; } r -= NEXP;
    if (r < NEXP) {
        unsigned char* dst = F.v8 + (size_t)r * PV_ROW;
        f32x4 v[2][8]; float ss = 0.f;
#pragma unroll
        for (int j = 0; j < 2; ++j) { const float* src = F.pv + (size_t)r * DM + j * 2048 + 4 * lane;
#pragma unroll
            for (int i = 0; i < 8; ++i) { v[j][i] = __builtin_nontemporal_load((const f32x4*)(src + 256 * i)); ss += (v[j][i].x * v[j][i].x + v[j][i].y * v[j][i].y) + (v[j][i].z * v[j][i].z + v[j][i].w * v[j][i].w); } }
        ss = wave_sum(ss);
        const float scl = ss > 0.f ? (2.6f / 6.f) * sqrtf(ss * (1.f / DM)) : 1.f, iv = 1.f / scl;
        if (lane == 0) F.usc[NEXP + r] = scl;
#pragma unroll
        for (int j = 0; j < 2; ++j) { unsigned wq[4];
#pragma unroll
            for (int d = 0; d < 4; ++d) { const f32x4 a = v[j][2 * d] * iv, c = v[j][2 * d + 1] * iv; unsigned w = 0u;
                w = __builtin_amdgcn_cvt_scalef32_pk_fp4_f32(w, a.x, a.y, 1.0f, 0); w = __builtin_amdgcn_cvt_scalef32_pk_fp4_f32(w, a.z, a.w, 1.0f, 1);
                w = __builtin_amdgcn_cvt_scalef32_pk_fp4_f32(w, c.x, c.y, 1.0f, 2); w = __builtin_amdgcn_cvt_scalef32_pk_fp4_f32(w, c.z, c.w, 1.0f, 3);
                wq[d] = w; }
            *(GAS v4u*)(dst + j * 1024 + lane * 16) = (v4u){wq[0], wq[1], wq[2], wq[3]}; }
        return; } r -= NEXP;
    if (r < I_WOUT) { p0_transpose_item<false>(F.w_out, DM, DM, DM, F.wout, scr, r, lane); return; } r -= I_WOUT;
    p0_transpose_item<false>(F.wq, DM, PQ_LD, PQ_LD, F.wqt, scr, r, lane);
}
__device__ __forceinline__ void p0_items(Frame& F) {
    LAS float* scr = (LAS float*)(F.lds + F.wave * 16640);
    gu32* ctr = F.ctl + 80;
    for (;;) {
        __syncthreads();
        if (F.tid == 0) F.MISC[12] = __hip_atomic_fetch_add(ctr, 1u, __ATOMIC_RELAXED, __HIP_MEMORY_SCOPE_AGENT);
        __syncthreads();
        const int it = (int)F.MISC[12] * NWAVES + F.wave;
        if (it - F.wave >= NITEMS_A) break;
        if (it < NITEMS_A) conv_item_a(F, it, scr);
    }
}
__device__ __forceinline__ unsigned pack_i8x4(float a, float b, float c, float d) {
    const int q0 = (int)rintf(a), q1 = (int)rintf(b), q2 = (int)rintf(c), q3 = (int)rintf(d);
    return (unsigned)(q0 & 255) | ((unsigned)(q1 & 255) << 8) | ((unsigned)(q2 & 255) << 16) | ((unsigned)q3 << 24);
}
__device__ __forceinline__ void quant_row_load(const bf16* src, int lane, v4u (&xr)[8]) {
#pragma unroll
    for (int j = 0; j < 8; ++j) xr[j] = *(const GAS v4u*)(src + j * 512 + lane * 8);
}
__device__ __forceinline__ void quant_row_store(const v4u (&xr)[8], signed char* dst, float* sc_slot, int lane) {
    float am = 0.f;
#pragma unroll
    for (int j = 0; j < 8; ++j) { const unsigned w[4] = {xr[j].x, xr[j].y, xr[j].z, xr[j].w};
#pragma unroll
        for (int q = 0; q < 4; ++q) am = fmaxf(am, fmaxf(fabsf(bf_lo(w[q])), fabsf(bf_hi(w[q])))); }
#pragma unroll
    for (int o = 1; o < 64; o <<= 1) am = fmaxf(am, __shfl_xor(am, o));
    const float s = am > 0.f ? 127.f / am : 1.f;
    if (lane == 0) *sc_slot = am > 0.f ? am * (1.f / 127.f) : 1.f;
#pragma unroll
    for (int j = 0; j < 8; ++j) { const unsigned w[4] = {xr[j].x, xr[j].y, xr[j].z, xr[j].w};
        const unsigned lo = pack_i8x4(bf_lo(w[0]) * s, bf_hi(w[0]) * s, bf_lo(w[1]) * s, bf_hi(w[1]) * s), hi = pack_i8x4(bf_lo(w[2]) * s, bf_hi(w[2]) * s, bf_lo(w[3]) * s, bf_hi(w[3]) * s);
        *(GAS unsigned long long*)(dst + j * 512 + lane * 8) = (unsigned long long)lo | ((unsigned long long)hi << 32); }
}
__device__ __forceinline__ void quant_rows_bf16_i8(const bf16* src, signed char* dst, float* sc, int r0, int stride, int nrows, int lane) {
    if (r0 >= nrows) return;
    v4u cur[8]; quant_row_load(src + (size_t)r0 * DM, lane, cur);
    for (int r = r0; r < nrows; r += stride) {
        v4u nxt[8]; const int rn = r + stride < nrows ? r + stride : r;
        quant_row_load(src + (size_t)rn * DM, lane, nxt); CBAR();
        quant_row_store(cur, dst + (size_t)r * DM, sc + r, lane);
#pragma unroll
        for (int j = 0; j < 8; ++j) cur[j] = nxt[j];
    }
}
template <typename XT>
__device__ __forceinline__ void modnorm_phase(Frame& F, const XT* xin, const float* g, int csh, int csc, bf16* outp, signed char* out8 = nullptr, float* sa8 = nullptr) {
    constexpr bool XB = sizeof(XT) == 2;
    LAS float* tA = (LAS float*)(F.lds);
    LAS float* tB = (LAS float*)(F.lds + 32768);
    int tid = F.tid; asm volatile("" : "+v"(tid));
    for (int i = tid; i < 2 * DM; i += NWAVES * 64) { const int b = i >> 12, k = i & (DM - 1);
        const float sc = F.modp[(size_t)b * NADA + csc * DM + k], sh = F.modp[(size_t)b * NADA + csh * DM + k];
        tA[i] = g[k] * (1.f + sc); tB[i] = sh; }
    __syncthreads();
    const int gw = blockIdx.x * NWAVES + F.wave, NGW = F.G * NWAVES, lane = F.lane;
    typedef typename std::conditional<XB, unsigned long long, f32x4>::type RawT;
    f32x4 v[16];
    if (gw < NTOK) { const GAS RawT* xr = (const GAS RawT*)(xin + (size_t)gw * DM) + lane;
#pragma unroll
        for (int j = 0; j < 16; ++j) { const RawT w = xr[64 * j];
            if constexpr (XB) { const unsigned lo = (unsigned)w, hi = (unsigned)(w >> 32); v[j] = (f32x4){bf_lo(lo), bf_hi(lo), bf_lo(hi), bf_hi(hi)}; } else v[j] = w; } }
    for (int row = gw; row < NTOK; row += NGW) {
        const int b = row >> 12;
        RawT nv[16];
        { const int rn = row + NGW < NTOK ? row + NGW : row; const GAS RawT* xr = (const GAS RawT*)(xin + (size_t)rn * DM) + lane;
#pragma unroll
          for (int j = 0; j < 16; ++j) nv[j] = xr[64 * j]; }
        CBAR();
        float s = 0.f;
#pragma unroll
        for (int j = 0; j < 16; ++j) s += (v[j].x * v[j].x + v[j].y * v[j].y) + (v[j].z * v[j].z + v[j].w * v[j].w);
        const float rs = 1.0f / sqrtf(wave_sum(s) * (1.f / DM) + NORM_EPS);
        GAS unsigned long long* o8 = (GAS unsigned long long*)(outp + (size_t)row * DM) + lane;
        float am = 0.f;
#pragma unroll
        for (int j = 0; j < 16; ++j) { const f32x4 a = *(const LAS f32x4*)(tA + b * DM + j * 256 + lane * 4), bb = *(const LAS f32x4*)(tB + b * DM + j * 256 + lane * 4);
            const f32x4 y = v[j] * rs * a + bb; v[j] = y;
            am = fmaxf(am, fmaxf(fmaxf(fabsf(y.x), fabsf(y.y)), fmaxf(fabsf(y.z), fabsf(y.w))));
            if (outp) o8[64 * j] = (unsigned long long)pk2(y.x, y.y) | ((unsigned long long)pk2(y.z, y.w) << 32);
            if ((j & 3) == 3) CBAR(); }
        if (out8) {
#pragma unroll
            for (int o = 1; o < 64; o <<= 1) am = fmaxf(am, __shfl_xor(am, o));
            const float s8 = am > 0.f ? 127.f / am : 1.f;
            if (lane == 0) sa8[row] = am > 0.f ? am * (1.f / 127.f) : 1.f;
            GAS unsigned* q8 = (GAS unsigned*)(out8 + (size_t)row * DM) + lane;
#pragma unroll
            for (int j = 0; j < 16; ++j) q8[64 * j] = pack_i8x4(v[j].x * s8, v[j].y * s8, v[j].z * s8, v[j].w * s8); }
#pragma unroll
        for (int j = 0; j < 16; ++j) { if constexpr (XB) { const unsigned lo = (unsigned)nv[j], hi = (unsigned)(nv[j] >> 32); v[j] = (f32x4){bf_lo(lo), bf_hi(lo), bf_lo(hi), bf_hi(hi)}; } else v[j] = nv[j]; }
    }
    __syncthreads();
}
constexpr int DIL_KROWS = 224, DIL_KSTR = 272, DIL_VSTR = 288, DIL_VOFF = DIL_KROWS * DIL_KSTR;
struct DilUnit { int br, b, kvh, dil, r, qt; };
__device__ __forceinline__ DilUnit dil_decode(int u) { DilUnit d; d.br = u >> 9; const int v = u & 511, w = v & 63, bk = v >> 6; d.b = bk >> 2; d.kvh = bk & 3; const int dsh = 2 * d.br; d.dil = 1 << dsh; d.r = w & (d.dil - 1); d.qt = w >> dsh; return d; }
__device__ __forceinline__ void dil_load_rows(Frame& F, const DilUnit& d, v4u (&rk)[7], v4u (&rv)[7]) {
    const bf16* base = F.proj + (size_t)d.b * SEQ * PROJ_LD;
#pragma unroll
    for (int i = 0; i < 7; ++i) { const int c = F.tid + 512 * i, lr = c >> 4, ch = c & 15, jk = 64 * d.qt - 128 + lr;
        rk[i] = (v4u){0u, 0u, 0u, 0u}; rv[i] = (v4u){0u, 0u, 0u, 0u};
        if (lr < 192 && jk >= 0) { const bf16* rowp = base + (size_t)(jk * d.dil + d.r) * PROJ_LD; rk[i] = *(const GAS v4u*)(rowp + C_KA + d.kvh * 128 + ch * 8); rv[i] = *(const GAS v4u*)(rowp + C_VA + d.kvh * 128 + ch * 8); } }
}
__device__ __forceinline__ void dil_store_rows(Frame& F, const v4u (&rk)[7], const v4u (&rv)[7]) {
#pragma unroll
    for (int i = 0; i < 7; ++i) { const int c = F.tid + 512 * i, lr = c >> 4, ch = c & 15;
        *(LAS v4u*)(F.lds + lr * DIL_KSTR + ch * 16) = rk[i]; *(LAS v4u*)(F.lds + DIL_VOFF + lr * DIL_VSTR + ch * 16) = rv[i]; }
}
__device__ __forceinline__ void dil_load_q(Frame& F, const DilUnit& d, bf16x8 (&qf)[2][4]) {
    const bf16* base = F.proj + (size_t)d.b * SEQ * PROJ_LD;
    const int lane = F.lane, wv = F.wave, n = lane & 15, rq = lane >> 4;
#pragma unroll
    for (int i = 0; i < 2; ++i) { const int rho = 16 * i + n, jq = 64 * d.qt + 8 * wv + (rho >> 2), g = rho & 3;
        const bf16* qp = base + (size_t)(jq * d.dil + d.r) * PROJ_LD + C_QA + (d.kvh * 4 + g) * 128 + 8 * rq;
#pragma unroll
        for (int ks = 0; ks < 4; ++ks) qf[i][ks] = *(const GAS bf16x8*)(qp + 32 * ks); }
}
__device__ __forceinline__ void dil_compute(Frame& F, const DilUnit& d, const bf16x8 (&qf)[2][4]) {
    const int br = d.br, b = d.b, kvh = d.kvh, dil = d.dil, r = d.r, qt = d.qt;
    LAS unsigned char* lds = F.lds;
    const int lane = F.lane, wv = F.wave, n = lane & 15, rq = lane >> 4;
    f32x4 o[8][2];
#pragma unroll
    for (int dt = 0; dt < 8; ++dt) { o[dt][0] = (f32x4){0.f, 0.f, 0.f, 0.f}; o[dt][1] = (f32x4){0.f, 0.f, 0.f, 0.f}; }
    float mrun[2] = {-1e30f, -1e30f}, lrun[2] = {0.f, 0.f};
    const float SC = 0.08838834764831845f * 1.4426950408889634f;
    const float NINF = -__builtin_inff();
    const int lrmin = 128 - 64 * qt;
    for (int s = 0; s < 5; ++s) {
        const int R0 = 8 * wv + 32 * s;
        f32x4 sa[2], sb[2];
        sa[0] = sa[1] = sb[0] = sb[1] = (f32x4){0.f, 0.f, 0.f, 0.f};
#pragma unroll
        for (int ks = 0; ks < 4; ++ks) {
            const bf16x8 ka = *(const LAS bf16x8*)(lds + (R0 + n) * DIL_KSTR + (32 * ks + 8 * rq) * 2);
            const bf16x8 kb = *(const LAS bf16x8*)(lds + (R0 + 16 + n) * DIL_KSTR + (32 * ks + 8 * rq) * 2);
#pragma unroll
            for (int i = 0; i < 2; ++i) { sa[i] = MFMA16(ka, qf[i][ks], sa[i]); sb[i] = MFMA16(kb, qf[i][ks], sb[i]); }
        }
        bf16x8 pf[2];
#pragma unroll
        for (int i = 0; i < 2; ++i) {
            const int qoff = 8 * wv + 128 + ((16 * i + n) >> 2);
            const int lrA = R0 + 4 * rq;
            float pa[4], pb[4]; float mx = NINF;
#pragma unroll
            for (int e = 0; e < 4; ++e) { const int la = lrA + e, lb = lrA + 16 + e;
                const bool oka = ((unsigned)(qoff - la) <= 128u) && (la >= lrmin), okb = ((unsigned)(qoff - lb) <= 128u) && (lb >= lrmin);
                pa[e] = oka ? sa[i][e] * SC : NINF; pb[e] = okb ? sb[i][e] * SC : NINF; mx = fmaxf(mx, fmaxf(pa[e], pb[e])); }
            mx = fmaxf(mx, __shfl_xor(mx, 16)); mx = fmaxf(mx, __shfl_xor(mx, 32));
            const float mn = fmaxf(mrun[i], mx), alpha = fexp2(mrun[i] - mn); mrun[i] = mn;
            float ps = 0.f;
#pragma unroll
            for (int e = 0; e < 4; ++e) { pa[e] = fexp2(pa[e] - mn); pb[e] = fexp2(pb[e] - mn); ps += pa[e] + pb[e]; }
            ps += __shfl_xor(ps, 16); ps += __shfl_xor(ps, 32);
            lrun[i] = lrun[i] * alpha + ps;
#pragma unroll
            for (int dt = 0; dt < 8; ++dt) o[dt][i] = o[dt][i] * alpha;
            v4u pw; pw.x = cvtpk(pa[0], pa[1]); pw.y = cvtpk(pa[2], pa[3]); pw.z = cvtpk(pb[0], pb[1]); pw.w = cvtpk(pb[2], pb[3]);
            pf[i] = __builtin_bit_cast(bf16x8, pw);
        }
#pragma unroll
        for (int dt = 0; dt < 8; ++dt) {
            const LAS unsigned char* vb = lds + DIL_VOFF + (R0 + 4 * rq + (n >> 2)) * DIL_VSTR + (16 * dt + 4 * (n & 3)) * 2;
            const s16x4 t1 = vtr(vb), t2 = vtr(vb + 16 * DIL_VSTR);
            const bf16x8 vf = {t1[0], t1[1], t1[2], t1[3], t2[0], t2[1], t2[2], t2[3]};
#pragma unroll
            for (int i = 0; i < 2; ++i) o[dt][i] = MFMA16(vf, pf[i], o[dt][i]);
        }
    }
#pragma unroll
    for (int i = 0; i < 2; ++i) { const int rho = 16 * i + n, jq = 64 * qt + 8 * wv + (rho >> 2), head = kvh * 4 + (rho & 3);
        const size_t tok = (size_t)b * SEQ + jq * dil + r; const float inv = 1.f / lrun[i];
        bf16* op = F.oap + ((size_t)br * NTOK + tok) * 2048 + head * 128 + 4 * rq;
#pragma unroll
        for (int dt = 0; dt < 8; ++dt) { const f32x4 x = o[dt][i] * inv; *(GAS unsigned long long*)(op + 16 * dt) = (unsigned long long)cvtpk(x[0], x[1]) | ((unsigned long long)cvtpk(x[2], x[3]) << 32); }
        if (rq == 0) F.lse[((size_t)br * NTOK + tok) * 16 + head] = mrun[i] + log2f(lrun[i]); }
}
__device__ __forceinline__ int p3_next(Frame& F, gu32* ctr) {
    __syncthreads();
    if (F.tid == 0) F.MISC[12] = __hip_atomic_fetch_add(ctr, 1u, __ATOMIC_RELAXED, __HIP_MEMORY_SCOPE_AGENT);
    __syncthreads();
    return (int)F.MISC[12];
}
__device__ __forceinline__ void dil_units(Frame& F, int u0, gu32* ctr, int nunits) {
    if (u0 >= nunits) return;
    v4u rk[7], rv[7]; bf16x8 qf[2][4];
    DilUnit d = dil_decode(u0);
    dil_load_rows(F, d, rk, rv); dil_load_q(F, d, qf);
    if (F.tid == 0) F.MISC[12] = __hip_atomic_fetch_add(ctr, 1u, __ATOMIC_RELAXED, __HIP_MEMORY_SCOPE_AGENT);
    for (;;) {
        __syncthreads();
        dil_store_rows(F, rk, rv);
        const int un = (int)F.MISC[12] - 320; const bool has_next = un < nunits;
        __syncthreads();
        unsigned nn = 0u;
        if (has_next && F.tid == 0) nn = __hip_atomic_fetch_add(ctr, 1u, __ATOMIC_RELAXED, __HIP_MEMORY_SCOPE_AGENT);
        DilUnit dn = d;
        if (has_next) { dn = dil_decode(un); dil_load_rows(F, dn, rk, rv); }
        CBAR();
        dil_compute(F, d, qf);
        if (!has_next) break;
        if (F.tid == 0) F.MISC[12] = nn;
        d = dn;
        dil_load_q(F, d, qf);
    }
    __syncthreads();
}
__device__ __forceinline__ float relu_f(float x) { return __builtin_amdgcn_fmed3f(x, 0.f, 3.0e38f); }
__device__ __forceinline__ void idx_unit(Frame& F, int u) {
    const int b = u / 160; int id = u % 160, i, c;
    if (id < 16) { i = id; c = 0; } else if (id < 48) { id -= 16; i = 16 + id / 2; c = id % 2; } else if (id < 96) { id -= 48; i = 32 + id / 3; c = id % 3; } else { id -= 96; i = 48 + id / 4; c = id % 4; }
    const int kbeg = 1024 * c, kend = min(1024 * (c + 1), 64 * (i + 1)), ntile = (kend - kbeg) >> 5;
    const bf16* base = F.proj + (size_t)b * SEQ * PROJ_LD;
    const int lane = F.lane, rho = lane & 31, hi = lane >> 5;
    const int t0 = 64 * i + 8 * F.wave;
    bf16x8 af[4][4]; v4u wq[4][2];
#pragma unroll
    for (int rt = 0; rt < 4; ++rt) {
        const bf16* qp = base + (size_t)(t0 + 2 * rt + ((rho >> 2) & 1)) * PROJ_LD + C_QI + ((rho & 3) + 4 * (rho >> 3)) * 64 + 8 * hi;
#pragma unroll
        for (int ks = 0; ks < 4; ++ks) af[rt][ks] = *(const GAS bf16x8*)(qp + 16 * ks);
        const bf16* wp = base + (size_t)(t0 + 2 * rt + hi) * PROJ_LD + C_WI; wq[rt][0] = *(const GAS v4u*)wp; wq[rt][1] = *(const GAS v4u*)(wp + 8);
    }
    float* srow = F.score + ((size_t)b * SEQ + t0 + hi) * SEQ + kbeg + rho;
    const bf16* kp = base + (size_t)(kbeg + rho) * PROJ_LD + C_KI + 8 * hi;
    bf16x8 bc[4];
#pragma unroll
    for (int ks = 0; ks < 4; ++ks) bc[ks] = *(const GAS bf16x8*)(kp + 16 * ks);
    for (int kt = 0; kt < ntile; ++kt) {
        bf16x8 bn[4];
        { const bf16* kn = kp + (size_t)(kt + 1 < ntile ? kt + 1 : kt) * 32 * PROJ_LD;
#pragma unroll
          for (int ks = 0; ks < 4; ++ks) bn[ks] = *(const GAS bf16x8*)(kn + 16 * ks); }
        f32x16 acc[4];
#pragma unroll
        for (int rt = 0; rt < 4; ++rt)
#pragma unroll
            for (int k = 0; k < 16; ++k) acc[rt][k] = 0.f;
#pragma unroll
        for (int ks = 0; ks < 4; ++ks)
#pragma unroll
            for (int rt = 0; rt < 4; ++rt) acc[rt] = MFMA32(af[rt][ks], bc[ks], acc[rt]);
#pragma unroll
        for (int rt = 0; rt < 4; ++rt) { float sc = 0.f; const unsigned ww[8] = {wq[rt][0].x, wq[rt][0].y, wq[rt][0].z, wq[rt][0].w, wq[rt][1].x, wq[rt][1].y, wq[rt][1].z, wq[rt][1].w};
#pragma unroll
            for (int k = 0; k < 8; ++k) { sc = fmaf(bf_lo(ww[k]), relu_f(acc[rt][2 * k]), sc); sc = fmaf(bf_hi(ww[k]), relu_f(acc[rt][2 * k + 1]), sc); }
            srow[(size_t)2 * rt * SEQ + 32 * kt] = sc * 0.03125f; }
#pragma unroll
        for (int ks = 0; ks < 4; ++ks) bc[ks] = bn[ks];
    }
}
constexpr int DSA_WLDS = 1024 + 32 * DIL_VSTR;
__device__ __forceinline__ unsigned pk_satsub_u16(unsigned a, unsigned b) { unsigned d; asm("v_pk_sub_u16 %0, %1, %2 clamp" : "=v"(d) : "v"(a), "v"(b)); return d; }
__device__ __forceinline__ unsigned pk_min_u16(unsigned a, unsigned b) { unsigned d; asm("v_pk_min_u16 %0, %1, %2" : "=v"(d) : "v"(a), "v"(b)); return d; }
__device__ __forceinline__ unsigned pk_add_u16(unsigned a, unsigned b) { unsigned d; asm("v_pk_add_u16 %0, %1, %2" : "=v"(d) : "v"(a), "v"(b)); return d; }
__device__ __forceinline__ unsigned pk_sub_u16(unsigned a, unsigned b) { unsigned d; asm("v_pk_sub_u16 %0, %1, %2" : "=v"(d) : "v"(a), "v"(b)); return d; }
__device__ __forceinline__ void dsa_token(Frame& F, int b_, int t_, LAS unsigned char* wl) {
    const int b = __builtin_amdgcn_readfirstlane(b_), t = __builtin_amdgcn_readfirstlane(t_);
    LAS int* sel = (LAS int*)wl; LAS unsigned char* vst = wl + 1024;
    const int lane = F.lane, n = lane & 15, rq = lane >> 4;
    const size_t tok = (size_t)b * SEQ + t; const int nvalid = t + 1;
    int nsel;
    if (nvalid <= 256) {
        nsel = nvalid;
#pragma unroll
        for (int i = 0; i < 4; ++i) { const int p = lane + 64 * i; sel[p] = p < nvalid ? p : 0; }
    } else {
        nsel = 256;
        const float* srow = F.score + tok * SEQ;
        unsigned u[64];
#pragma unroll
        for (int j = 0; j < 16; ++j) { f32x4 v = (f32x4){0.f, 0.f, 0.f, 0.f}; if (j <= (t >> 8)) v = *(const GAS f32x4*)(srow + j * 256 + lane * 4);
#pragma unroll
            for (int c = 0; c < 4; ++c) { const int idx = j * 256 + lane * 4 + c; const unsigned bits = __float_as_uint(v[c]); const unsigned key = bits ^ ((bits >> 31) ? 0xFFFFFFFFu : 0x80000000u); u[j * 4 + c] = idx <= t ? key : 0u; } }
        const int jmax = t >> 8;
        unsigned T; bool exact = false;
        { unsigned H[32];
#pragma unroll
          for (int i = 0; i < 32; ++i) H[i] = __builtin_amdgcn_perm(u[2 * i + 1], u[2 * i], 0x07060302u);
          unsigned TH = 0u;
          for (int bit = 15; bit >= 0; --bit) { const unsigned c16 = TH | (1u << bit), cm1 = (c16 - 1u) * 0x10001u; unsigned acc = 0u;
#pragma unroll
              for (int j = 0; j < 16; ++j) if (j <= jmax) {
#pragma unroll
                  for (int q = 0; q < 2; ++q) acc = pk_add_u16(acc, pk_min_u16(pk_satsub_u16(H[2 * j + q], cm1), 0x00010001u)); }
              const int tot = wave_sum_i((int)((acc & 0xFFFFu) + (acc >> 16)));
              if (tot >= 256) { TH = c16; if (tot == 256) { exact = true; break; } } }
          T = TH << 16;
          if (!exact) {
              int ngt = 0;
              if (TH != 0xFFFFu) { const unsigned cm1 = TH * 0x10001u; unsigned acc = 0u;
#pragma unroll
                  for (int j = 0; j < 16; ++j) if (j <= jmax) {
#pragma unroll
                      for (int q = 0; q < 2; ++q) acc = pk_add_u16(acc, pk_min_u16(pk_satsub_u16(H[2 * j + q], cm1), 0x00010001u)); }
                  ngt = wave_sum_i((int)((acc & 0xFFFFu) + (acc >> 16))); }
              const int need = 256 - ngt;
              const unsigned THp = TH * 0x10001u;
#pragma unroll
              for (int i = 0; i < 32; ++i) { const unsigned ne = pk_min_u16(H[i] ^ THp, 0x00010001u);
                  H[i] = __builtin_amdgcn_perm(u[2 * i + 1], u[2 * i], 0x05040100u) & pk_sub_u16(ne, 0x00010001u); }
              unsigned TL = 0u;
              for (int bit = 15; bit >= 0; --bit) { const unsigned c16 = TL | (1u << bit), cm1 = (c16 - 1u) * 0x10001u; unsigned acc = 0u;
#pragma unroll
                  for (int j = 0; j < 16; ++j) if (j <= jmax) {
#pragma unroll
                      for (int q = 0; q < 2; ++q) acc = pk_add_u16(acc, pk_min_u16(pk_satsub_u16(H[2 * j + q], cm1), 0x00010001u)); }
                  const int tot = wave_sum_i((int)((acc & 0xFFFFu) + (acc >> 16)));
                  if (tot >= need) { TL = c16; if (tot == need) { exact = true; break; } } }
              T |= TL; } }
        int basep = 0;
#pragma unroll
        for (int k = 0; k < 64; ++k) if ((k >> 2) <= jmax) { const bool gt = exact ? (u[k] >= T) : (u[k] > T); const unsigned long long m = __ballot(gt);
            const int p = basep + (int)__builtin_amdgcn_mbcnt_hi((unsigned)(m >> 32), __builtin_amdgcn_mbcnt_lo((unsigned)m, 0u));
            if (gt) sel[p] = (k >> 2) * 256 + lane * 4 + (k & 3); basep += __popcll(m); }
        if (!exact)
#pragma unroll
        for (int k = 0; k < 64; ++k) if ((k >> 2) <= jmax) { const bool eq = u[k] == T; const unsigned long long m = __ballot(eq);
            const int p = basep + (int)__builtin_amdgcn_mbcnt_hi((unsigned)(m >> 32), __builtin_amdgcn_mbcnt_lo((unsigned)m, 0u));
            if (eq && p < 256) sel[p] = (k >> 2) * 256 + lane * 4 + (k & 3); basep += __popcll(m); }
    }
    LDS_WAIT(); CBAR();
    const bf16* pb = F.proj + (size_t)b * SEQ * PROJ_LD;
    bf16x8 qf[4];
    { const bf16* qp = F.proj + tok * PROJ_LD + C_QB + n * 128 + 8 * rq;
#pragma unroll
      for (int ks = 0; ks < 4; ++ks) qf[ks] = *(const GAS bf16x8*)(qp + 32 * ks); }
    f32x4 o[8];
#pragma unroll
    for (int dt = 0; dt < 8; ++dt) o[dt] = (f32x4){0.f, 0.f, 0.f, 0.f};
    float mrun = -1e30f, lrun = 0.f;
    const float SC = 0.08838834764831845f * 1.4426950408889634f, NINF = -__builtin_inff();
    const int nsteps = (nsel + 31) >> 5;
    bf16x8 kf[8]; v4u vr[8];
    { const int ka = sel[n], kb = sel[16 + n]; int vk[8];
#pragma unroll
      for (int cc = 0; cc < 8; ++cc) vk[cc] = sel[cc * 4 + rq];
      const bf16* pa_ = pb + (size_t)ka * PROJ_LD + C_KB + 8 * rq; const bf16* pb_ = pb + (size_t)kb * PROJ_LD + C_KB + 8 * rq;
#pragma unroll
      for (int ks = 0; ks < 4; ++ks) { kf[ks] = *(const GAS bf16x8*)(pa_ + 32 * ks); kf[4 + ks] = *(const GAS bf16x8*)(pb_ + 32 * ks); }
#pragma unroll
      for (int cc = 0; cc < 8; ++cc) vr[cc] = *(const GAS v4u*)(pb + (size_t)vk[cc] * PROJ_LD + C_VB + n * 8); }
    for (int s = 0; s < nsteps; ++s) {
        const int i0 = 32 * s;
#pragma unroll
        for (int cc = 0; cc < 8; ++cc) *(LAS v4u*)(vst + (cc * 4 + rq) * DIL_VSTR + n * 16) = vr[cc];
        bf16x8 kn[8];
        { const int i1 = (s + 1 < nsteps) ? i0 + 32 : i0;
          const int ka = sel[i1 + n], kb = sel[i1 + 16 + n]; int vk[8];
#pragma unroll
          for (int cc = 0; cc < 8; ++cc) vk[cc] = sel[i1 + cc * 4 + rq];
          const bf16* pa_ = pb + (size_t)ka * PROJ_LD + C_KB + 8 * rq; const bf16* pb_ = pb + (size_t)kb * PROJ_LD + C_KB + 8 * rq;
#pragma unroll
          for (int ks = 0; ks < 4; ++ks) { kn[ks] = *(const GAS bf16x8*)(pa_ + 32 * ks); kn[4 + ks] = *(const GAS bf16x8*)(pb_ + 32 * ks); }
#pragma unroll
          for (int cc = 0; cc < 8; ++cc) vr[cc] = *(const GAS v4u*)(pb + (size_t)vk[cc] * PROJ_LD + C_VB + n * 8); }
        f32x4 sa = (f32x4){0.f, 0.f, 0.f, 0.f}, sb = sa;
#pragma unroll
        for (int ks = 0; ks < 4; ++ks) { sa = MFMA16(kf[ks], qf[ks], sa); sb = MFMA16(kf[4 + ks], qf[ks], sb); }
        float pa[4], pbv[4]; float mx = NINF;
#pragma unroll
        for (int e = 0; e < 4; ++e) { const int pA = i0 + 4 * rq + e, pB = pA + 16;
            pa[e] = pA < nsel ? sa[e] * SC : NINF; pbv[e] = pB < nsel ? sb[e] * SC : NINF; mx = fmaxf(mx, fmaxf(pa[e], pbv[e])); }
        mx = fmaxf(mx, __shfl_xor(mx, 16)); mx = fmaxf(mx, __shfl_xor(mx, 32));
        const float mn = fmaxf(mrun, mx), alpha = fexp2(mrun - mn); mrun = mn;
        float ps = 0.f;
#pragma unroll
        for (int e = 0; e < 4; ++e) { pa[e] = fexp2(pa[e] - mn); pbv[e] = fexp2(pbv[e] - mn); ps += pa[e] + pbv[e]; }
        ps += __shfl_xor(ps, 16); ps += __shfl_xor(ps, 32);
        lrun = lrun * alpha + ps;
#pragma unroll
        for (int dt = 0; dt < 8; ++dt) o[dt] = o[dt] * alpha;
        v4u pw; pw.x = cvtpk(pa[0], pa[1]); pw.y = cvtpk(pa[2], pa[3]); pw.z = cvtpk(pbv[0], pbv[1]); pw.w = cvtpk(pbv[2], pbv[3]);
        const bf16x8 pf = __builtin_bit_cast(bf16x8, pw);
        LDS_WAIT(); CBAR();
#pragma unroll
        for (int dt = 0; dt < 8; ++dt) {
#if !DSA_TR
            bf16x8 vf;
#pragma unroll
            for (int j = 0; j < 4; ++j) { vf[j] = *(const LAS short*)(vst + (4 * rq + j) * DIL_VSTR + (16 * dt + n) * 2); vf[4 + j] = *(const LAS short*)(vst + (16 + 4 * rq + j) * DIL_VSTR + (16 * dt + n) * 2); }
#else
            const LAS unsigned char* vb = vst + (4 * rq + (n >> 2)) * DIL_VSTR + (16 * dt + 4 * (n & 3)) * 2;
            const s16x4 t1 = vtr(vb), t2 = vtr(vb + 16 * DIL_VSTR);
            const bf16x8 vf = {t1[0], t1[1], t1[2], t1[3], t2[0], t2[1], t2[2], t2[3]};
#endif
            o[dt] = MFMA16(vf, pf, o[dt]);
        }
        LDS_WAIT(); CBAR();
#pragma unroll
        for (int k = 0; k < 8; ++k) kf[k] = kn[k];
    }
    { const float inv = 1.f / lrun; float am = 0.f;
#pragma unroll
      for (int dt = 0; dt < 8; ++dt) { o[dt] = o[dt] * inv; am = fmaxf(am, fmaxf(fmaxf(fabsf(o[dt][0]), fabsf(o[dt][1])), fmaxf(fabsf(o[dt][2]), fabsf(o[dt][3])))); }
      const int head = lane >> 2, d0 = (lane & 3) * 32;
      const float l0 = F.lse[((size_t)0 * NTOK + tok) * 16 + head], l1 = F.lse[((size_t)1 * NTOK + tok) * 16 + head], l2 = F.lse[((size_t)2 * NTOK + tok) * 16 + head];
      const float lm = fmaxf(l0, fmaxf(l1, l2)); float w0 = fexp2(l0 - lm), w1 = fexp2(l1 - lm), w2 = fexp2(l2 - lm); const float ws = 1.f / (w0 + w1 + w2); w0 *= ws; w1 *= ws; w2 *= ws;
      const bf16* p0 = F.oap + ((size_t)0 * NTOK + tok) * 2048 + head * 128 + d0; const bf16* p1 = F.oap + ((size_t)1 * NTOK + tok) * 2048 + head * 128 + d0; const bf16* p2 = F.oap + ((size_t)2 * NTOK + tok) * 2048 + head * 128 + d0;
      float oa[32];
#pragma unroll
      for (int j = 0; j < 4; ++j) { const v4u a = *(const GAS v4u*)(p0 + 8 * j), bq = *(const GAS v4u*)(p1 + 8 * j), cq = *(const GAS v4u*)(p2 + 8 * j);
          const unsigned aa[4] = {a.x, a.y, a.z, a.w}, bb[4] = {bq.x, bq.y, bq.z, bq.w}, cc[4] = {cq.x, cq.y, cq.z, cq.w};
#pragma unroll
          for (int k = 0; k < 4; ++k) { const float lo = w0 * bf_lo(aa[k]) + w1 * bf_lo(bb[k]) + w2 * bf_lo(cc[k]), hi = w0 * bf_hi(aa[k]) + w1 * bf_hi(bb[k]) + w2 * bf_hi(cc[k]);
              oa[8 * j + 2 * k] = lo; oa[8 * j + 2 * k + 1] = hi; am = fmaxf(am, fmaxf(fabsf(lo), fabsf(hi))); } }
#pragma unroll
      for (int of = 1; of < 64; of <<= 1) am = fmaxf(am, __shfl_xor(am, of));
      const float s8 = am > 0.f ? 127.f / am : 1.f;
      if (lane == 0) F.sao[tok] = am > 0.f ? am * (1.f / 127.f) : 1.f;
      signed char* orow = F.o8 + tok * DM;
#pragma unroll
      for (int dt = 0; dt < 8; ++dt) *(GAS unsigned*)(orow + 2048 + n * 128 + 16 * dt + 4 * rq) = pack_i8x4(o[dt][0] * s8, o[dt][1] * s8, o[dt][2] * s8, o[dt][3] * s8);
#pragma unroll
      for (int j = 0; j < 4; ++j) { const unsigned lo = pack_i8x4(oa[8 * j] * s8, oa[8 * j + 1] * s8, oa[8 * j + 2] * s8, oa[8 * j + 3] * s8), hi = pack_i8x4(oa[8 * j + 4] * s8, oa[8 * j + 5] * s8, oa[8 * j + 6] * s8, oa[8 * j + 7] * s8);
          *(GAS unsigned long long*)(orow + head * 128 + d0 + 8 * j) = (unsigned long long)lo | ((unsigned long long)hi << 32); } }
}
__device__ __forceinline__ constexpr int cand_a(int ci) { return ci < 16 ? 0 : ci < 24 ? 1 : ci < 29 ? 2 : ci < 33 ? 3 : ci < 36 ? 4 : ci < 38 ? 5 : ci < 40 ? 6 : ci < 42 ? 7 : ci - 34; }
__device__ __forceinline__ constexpr int cand_b(int ci) { return ci < 16 ? ci : ci < 24 ? ci - 16 : ci < 29 ? ci - 24 : ci < 33 ? ci - 29 : ci < 36 ? ci - 33 : ci < 38 ? ci - 36 : ci < 40 ? ci - 38 : ci < 42 ? ci - 40 : 0; }
__device__ __forceinline__ float max3f(float a, float b, float c) { return fmaxf(a, fmaxf(b, c)); }
__device__ __forceinline__ int sortable_i(float f) { const int b = __float_as_int(f); return b ^ ((b >> 31) & 0x7FFFFFFF); }
__device__ __forceinline__ float unsortable_f(int k) { return __int_as_float(k ^ ((k >> 31) & 0x7FFFFFFF)); }
__device__ __forceinline__ void sort16_desc(int (&x)[16]) {
#pragma unroll
    for (int k = 2; k <= 16; k <<= 1)
#pragma unroll
        for (int j = k >> 1; j > 0; j >>= 1)
#pragma unroll
            for (int i = 0; i < 16; ++i) { const int l = i ^ j; if (l > i) { const int hi = max(x[i], x[l]), lo = min(x[i], x[l]); if ((i & k) == 0) { x[i] = hi; x[l] = lo; } else { x[i] = lo; x[l] = hi; } } }
}
__device__ __forceinline__ void merge16_desc(int (&x)[16]) {
#pragma unroll
    for (int j = 8; j > 0; j >>= 1)
#pragma unroll
        for (int i = 0; i < 16; ++i) { const int l = i ^ j; if (l > i) { const int hi = max(x[i], x[l]), lo = min(x[i], x[l]); x[i] = hi; x[l] = lo; } }
}
constexpr int RT_STR = 272;
__device__ __forceinline__ void peer_route(Frame& F, int tok0, int h, const LAS unsigned char* skl, int* REg, float* RGg) {
    const int lane = F.lane, n = lane & 15, rq = lane >> 4;
    const float NINF = -__builtin_inff();
    float top[2][16];
#pragma unroll
    for (int p = 0; p < 2; ++p) {
        f32x4 sc[8];
#pragma unroll
        for (int mt = 0; mt < 8; ++mt) sc[mt] = (f32x4){0.f, 0.f, 0.f, 0.f};
        const bf16* qp = F.pq + (size_t)(tok0 + n) * PQ_LD + h * 256 + p * 128 + 8 * rq;
        int koff = (p * 128 + n) * RT_STR + 16 * rq; asm volatile("" : "+v"(koff));
        const LAS unsigned char* kp = skl + koff;
#pragma unroll
        for (int ks = 0; ks < 4; ++ks) { const bf16x8 qb = *(const GAS bf16x8*)(qp + 32 * ks);
#pragma unroll
            for (int mt = 0; mt < 8; ++mt) { const bf16x8 kf = *(const LAS bf16x8*)(kp + mt * 16 * RT_STR + 64 * ks); sc[mt] = MFMA16(kf, qb, sc[mt]); }
            CBAR(); }
        int va[16], vb[16];
        unsigned rq4 = 4u * (unsigned)rq; asm volatile("" : "+v"(rq4));
#pragma unroll
        for (int mt = 0; mt < 8; ++mt)
#pragma unroll
            for (int e = 0; e < 4; ++e) { const unsigned idx = 16 * mt + rq4 + e; const int key = sortable_i(__uint_as_float((__float_as_uint(sc[mt][e]) & ~127u) | (127u - idx)));
                if (mt < 4) va[mt * 4 + e] = key; else vb[(mt - 4) * 4 + e] = key; }
        sort16_desc(va); sort16_desc(vb);
#pragma unroll
        for (int i = 0; i < 16; ++i) va[i] = max(va[i], vb[15 - i]);
        merge16_desc(va);
#pragma unroll
        for (int lv = 16; lv <= 32; lv <<= 1) {
#pragma unroll
            for (int i = 0; i < 16; ++i) vb[i] = __shfl_xor(va[15 - i], lv);
#pragma unroll
            for (int i = 0; i < 16; ++i) va[i] = max(va[i], vb[i]);
            merge16_desc(va);
        }
#pragma unroll
        for (int rd = 0; rd < 16; ++rd) top[p][rd] = unsortable_f(va[rd]);
    }
    int i1v[16], i2v[16];
#pragma unroll
    for (int a = 0; a < 16; ++a) { i1v[a] = 127 - (int)(__float_as_uint(top[0][a]) & 127u); i2v[a] = 127 - (int)(__float_as_uint(top[1][a]) & 127u); }
    float val[13]; int eid[13];
#pragma unroll
    for (int k = 0; k < 13; ++k) { val[k] = NINF; eid[k] = -1;
#pragma unroll
        for (int q = 0; q < 4; ++q) { const int ci = 4 * k + q;
            if (ci < 50) { const float s = top[0][cand_a(ci)] + top[1][cand_b(ci)]; const float sk = __uint_as_float((__float_as_uint(s) & ~63u) | (unsigned)(63 - ci)); const int e = i1v[cand_a(ci)] * 128 + i2v[cand_b(ci)];
                if (rq == q) { val[k] = sk; eid[k] = e; } } } }
    float ws[16]; int we[16];
#pragma unroll
    for (int rd = 0; rd < 16; ++rd) {
        float best = val[0];
#pragma unroll
        for (int k = 1; k < 13; ++k) best = fmaxf(best, val[k]);
        best = fmaxf(best, __shfl_xor(best, 16)); best = fmaxf(best, __shfl_xor(best, 32));
        int es = -1;
#pragma unroll
        for (int k = 0; k < 13; ++k) { const bool m = (val[k] == best); es = m ? eid[k] : es; val[k] = m ? NINF : val[k]; }
        es = max(es, __shfl_xor(es, 16)); es = max(es, __shfl_xor(es, 32));
        ws[rd] = best; we[rd] = es;
    }
    float ex[16]; float sum = 0.f;
#pragma unroll
    for (int k = 0; k < 16; ++k) { ex[k] = expf(ws[k] - ws[0]); sum += ex[k]; }
    const float inv = 1.f / sum;
    if (rq == 0) {
        int* rep = REg + (size_t)(tok0 + n) * 128 + h * 16; float* rgp = RGg + (size_t)(tok0 + n) * 128 + h * 16;
#pragma unroll
        for (int k = 0; k < 16; k += 4) { *(GAS v4u*)(rep + k) = (v4u){(unsigned)we[k], (unsigned)we[k + 1], (unsigned)we[k + 2], (unsigned)we[k + 3]};
            *(GAS f32x4*)(rgp + k) = (f32x4){ex[k] * inv, ex[k + 1] * inv, ex[k + 2] * inv, ex[k + 3] * inv}; }
    }
}
__device__ __forceinline__ void route_tile(Frame& FF, int pm, int h) {
    Frame F = FF; unsigned z_ = 0u; asm volatile("" : "+v"(z_)); const int ln_ = (int)__builtin_amdgcn_mbcnt_hi(~0u, __builtin_amdgcn_mbcnt_lo(~0u, z_)); F.lane = ln_; F.tid = FF.wave * 64 + ln_;
    const bf16* src = F.sk + (size_t)h * 2 * 128 * 128;
#pragma unroll
    for (int i = 0; i < 8; ++i) { const int c = F.tid + 512 * i, row = c >> 4, ch = c & 15; *(LAS v4u*)(F.lds + row * RT_STR + ch * 16) = *(const GAS v4u*)(src + row * 128 + ch * 8); }
    __syncthreads();
#pragma unroll 1
    for (int j = 0; j < 2; ++j) peer_route(F, pm * 256 + j * 128 + 16 * F.wave, h, F.lds, F.reg, F.rgg);
    __syncthreads();
}
constexpr int PX_STR = 4112;
constexpr int PL_XQ = 0, PL_G2 = 16 * PX_STR, PL_LNF = PL_G2 + 16384, PL_RE = PL_LNF + 16384, PL_RG = PL_RE + 8192, PL_ACT = PL_RG + 8192, PL_SKEY = PL_ACT + 8192,
              PL_HIST = PL_SKEY + 8192, PL_PREF = PL_HIST + 1024, PL_SXI = PL_PREF + 1024, PL_XS = PL_SXI + 256, PL_WSCR = PL_XS + 512, PL_END = PL_WSCR + 8 * 1536;
static_assert(PL_END <= LDSCTL_OFF, "PEER LDS map");
__device__ __forceinline__ void peer_quant_token(Frame& F, int tok, LAS unsigned char* xq, LAS float* sxi_slot, LAS int* xs_row) {
    const int lane = F.lane; const signed char* src = F.h8 + (size_t)tok * DM;
    unsigned long long w[8];
#pragma unroll
    for (int j = 0; j < 8; ++j) w[j] = *(const GAS unsigned long long*)(src + j * 512 + lane * 8);
    if (lane == 0) *sxi_slot = F.sah[tok];
#pragma unroll
    for (int j = 0; j < 8; ++j) { *(LAS unsigned long long*)(xq + j * 512 + lane * 8) = w[j]; const int lo = (int)(unsigned)w[j], hi = (int)(unsigned)(w[j] >> 32);
        int sm = ((lo << 24) >> 24) + ((lo << 16) >> 24) + ((lo << 8) >> 24) + (lo >> 24) + ((hi << 24) >> 24) + ((hi << 16) >> 24) + ((hi << 8) >> 24) + (hi >> 24);
        sm = wave_sum_i(sm); if (lane == 0) xs_row[j] = sm; }
}
__device__ __forceinline__ void peer_token_v(Frame& F, int tok, int tl, const LAS unsigned* skey, const LAS float* act_all, LAS unsigned char* wl, const LAS float* g2, const LAS float* lnf, const bf16* x1) {
    const int lane = F.lane;
    LAS int* se = (LAS int*)wl; LAS float* sa = (LAS float*)(wl + 512);
    { int cnt = 0;
#pragma unroll 4
      for (int it = 0; it < 32; ++it) { const unsigned key = skey[it * 64 + lane]; const bool m = (int)((key >> 7) & 15u) == tl;
          const unsigned long long bm = __ballot(m); const int pos = cnt + (int)__builtin_amdgcn_mbcnt_hi((unsigned)(bm >> 32), __builtin_amdgcn_mbcnt_lo((unsigned)bm, 0u));
          if (m) { se[pos] = (int)(key >> 11); sa[pos] = act_all[key & 2047u]; } cnt += __popcll(bm); } }
    LDS_WAIT(); CBAR();
    f32x2v outv[32];
#pragma unroll
    for (int k = 0; k < 32; ++k) outv[k] = (f32x2v){0.f, 0.f};
#define PV_LOAD(c0_, c1_, cs_, kk_) { const int kq_ = (kk_) < 127 ? (kk_) : 127; const int e_ = __builtin_amdgcn_readfirstlane(se[kq_]); const unsigned char* vp_ = F.v8 + (size_t)e_ * PV_ROW; \
      c0_ = *(const GAS v4u*)(vp_ + lane * 16); c1_ = *(const GAS v4u*)(vp_ + 1024 + lane * 16); CBAR(); }
#define PV_FMA(c0_, c1_, cs_, kk_) { const float act_ = sa[kk_]; const f32x2v c2_ = (f32x2v){act_, act_}; \
      const unsigned w_[8] = {c0_.x, c0_.y, c0_.z, c0_.w, c1_.x, c1_.y, c1_.z, c1_.w}; \
      _Pragma("unroll") for (int d = 0; d < 8; ++d) { \
        outv[4 * d + 0] = __builtin_elementwise_fma(__builtin_amdgcn_cvt_scalef32_pk_f32_fp4(w_[d], 1.0f, 0), c2_, outv[4 * d + 0]);        \
        outv[4 * d + 1] = __builtin_elementwise_fma(__builtin_amdgcn_cvt_scalef32_pk_f32_fp4(w_[d], 1.0f, 1), c2_, outv[4 * d + 1]); \
        outv[4 * d + 2] = __builtin_elementwise_fma(__builtin_amdgcn_cvt_scalef32_pk_f32_fp4(w_[d], 1.0f, 2), c2_, outv[4 * d + 2]); \
        outv[4 * d + 3] = __builtin_elementwise_fma(__builtin_amdgcn_cvt_scalef32_pk_f32_fp4(w_[d], 1.0f, 3), c2_, outv[4 * d + 3]); } }
    { v4u a0, a1, b0, b1, c0, c1, d0, d1; const unsigned as = 0u, bs = 0u, cs = 0u, ds = 0u; (void)as; (void)bs; (void)cs; (void)ds;
      PV_LOAD(a0, a1, as, 0) PV_LOAD(b0, b1, bs, 1) PV_LOAD(c0, c1, cs, 2)
#pragma unroll 1
      for (int k = 0; k < 128; k += 4) {
          PV_LOAD(d0, d1, ds, k + 3) PV_FMA(a0, a1, as, k)
          PV_LOAD(a0, a1, as, k + 4) PV_FMA(b0, b1, bs, k + 1)
          PV_LOAD(b0, b1, bs, k + 5) PV_FMA(c0, c1, cs, k + 2)
          PV_LOAD(c0, c1, cs, k + 6) PV_FMA(d0, d1, ds, k + 3)
      } }
#undef PV_LOAD
#undef PV_FMA
    float ss = 0.f;
    int lt = lane; asm volatile("" : "+v"(lt));
#pragma unroll
    for (int j = 0; j < 2; ++j) {
#pragma unroll
        for (int i = 0; i < 8; ++i) { const int k = j * 2048 + 256 * i + 4 * lt; const unsigned long long xw = *(const GAS unsigned long long*)(x1 + (size_t)tok * DM + k); const unsigned xl = (unsigned)xw, xh = (unsigned)(xw >> 32); const f32x4 xv = {bf_lo(xl), bf_hi(xl), bf_lo(xh), bf_hi(xh)}; const f32x4 gv = *(const LAS f32x4*)(g2 + k);
            f32x2v y0 = outv[16 * j + 2 * i], y1 = outv[16 * j + 2 * i + 1];
            y0.x = xv[0] + gv[0] * y0.x; y0.y = xv[1] + gv[1] * y0.y; y1.x = xv[2] + gv[2] * y1.x; y1.y = xv[3] + gv[3] * y1.y;
            outv[16 * j + 2 * i] = y0; outv[16 * j + 2 * i + 1] = y1; ss += (y0.x * y0.x + y0.y * y0.y) + (y1.x * y1.x + y1.y * y1.y); } }
    const float rs = 1.0f / sqrtf(wave_sum(ss) * (1.f / DM) + NORM_EPS);
#pragma unroll
    for (int j = 0; j < 2; ++j) {
#pragma unroll
        for (int i = 0; i < 8; ++i) { const int k = j * 2048 + 256 * i + 4 * lt; const f32x4 lv = *(const LAS f32x4*)(lnf + k); const f32x2v y0 = outv[16 * j + 2 * i], y1 = outv[16 * j + 2 * i + 1];
            const f32x4 y = {y0.x * rs * lv[0], y0.y * rs * lv[1], y1.x * rs * lv[2], y1.y * rs * lv[3]};
            *(GAS f32x4*)(F.out + (size_t)tok * DM + k) = y; } }
}
__device__ __forceinline__ void peer_phase(Frame& FF, const bf16* x1) {
    LAS unsigned char* L = FF.lds;
    LAS unsigned char* XQ = L + PL_XQ; LAS float* g2 = (LAS float*)(L + PL_G2); LAS float* lnf = (LAS float*)(L + PL_LNF); LAS int* RE = (LAS int*)(L + PL_RE); LAS float* RG = (LAS float*)(L + PL_RG);
    LAS float* ACT = (LAS float*)(L + PL_ACT); LAS unsigned* SKEY = (LAS unsigned*)(L + PL_SKEY); LAS int* HIST = (LAS int*)(L + PL_HIST); LAS int* PREF = (LAS int*)(L + PL_PREF);
    LAS float* SXI = (LAS float*)(L + PL_SXI); LAS int* XS = (LAS int*)(L + PL_XS);
    { int t0 = FF.wave * 64 + (int)__builtin_amdgcn_mbcnt_hi(~0u, __builtin_amdgcn_mbcnt_lo(~0u, 0u)); asm volatile("" : "+v"(t0)); for (int i = t0; i < DM; i += NWAVES * 64) lnf[i] = FF.lnfg[i]; }
    for (int unit = blockIdx.x; unit < NTOK / 16; unit += FF.G) {
        Frame F = FF; unsigned z_ = 0u; asm volatile("" : "+v"(z_)); const int ln_ = (int)__builtin_amdgcn_mbcnt_hi(~0u, __builtin_amdgcn_mbcnt_lo(~0u, z_)); F.lane = ln_; F.tid = FF.wave * 64 + ln_; const int tid = F.tid;
        const int lane = F.lane, n = lane & 15, kg = lane >> 4;
        LAS unsigned char* WL = L + PL_WSCR + F.wave * 1536;
        const int tok0 = unit * 16, b = tok0 >> 12;
        for (int i = tid; i < DM; i += NWAVES * 64) g2[i] = F.modp[(size_t)b * NADA + 5 * DM + i];
        { const int i = tid; ((LAS v4u*)RE)[i] = *((const GAS v4u*)(F.reg + (size_t)tok0 * 128) + i); ((LAS f32x4*)RG)[i] = *((const GAS f32x4*)(F.rgg + (size_t)tok0 * 128) + i); }
#pragma unroll 1
        for (int tt = 0; tt < 2; ++tt) peer_quant_token(F, tok0 + 2 * F.wave + tt, XQ + (2 * F.wave + tt) * PX_STR, SXI + 2 * F.wave + tt, XS + (2 * F.wave + tt) * 8);
        if (tid < 256) HIST[tid] = 0;
#pragma unroll
        for (int i = 0; i < 4; ++i) ACT[tid + 512 * i] = 0.f;
        __syncthreads();
        unsigned key[4]; int pos[4];
#pragma unroll
        for (int i = 0; i < 4; ++i) { const int p = tid + 512 * i; const int e = RE[p]; key[i] = ((unsigned)e << 11) | (unsigned)p; pos[i] = __hip_atomic_fetch_add(HIST + (e >> 6), 1, __ATOMIC_RELAXED, __HIP_MEMORY_SCOPE_WORKGROUP); }
        __syncthreads();
        if (F.wave == 0) { const int h0 = HIST[4 * lane], h1 = HIST[4 * lane + 1], h2 = HIST[4 * lane + 2], h3 = HIST[4 * lane + 3]; const int v = h0 + h1 + h2 + h3; int inc = v;
#pragma unroll
            for (int o = 1; o < 64; o <<= 1) { const int up = __builtin_amdgcn_ds_bpermute(((lane - o) & 63) << 2, inc); if (lane >= o) inc += up; }
            const int ex = inc - v; PREF[4 * lane] = ex; PREF[4 * lane + 1] = ex + h0; PREF[4 * lane + 2] = ex + h0 + h1; PREF[4 * lane + 3] = ex + h0 + h1 + h2; }
        __syncthreads();
#pragma unroll
        for (int i = 0; i < 4; ++i) SKEY[PREF[key[i] >> 17] + pos[i]] = key[i];
        __syncthreads();
        {
            const int koff = F.wave * 256 + 16 * kg;
#define PU_LOAD(buf, key_, g_) { key_ = SKEY[16 * ((g_) < 127 ? (g_) : 127) + n]; const unsigned char* up_ = F.u8 + (size_t)(key_ >> 11) * (DM / 2) + koff; \
              buf[0] = *(const GAS v4u*)(up_); buf[1] = *(const GAS v4u*)(up_ + 64); buf[2] = *(const GAS v4u*)(up_ + 128); buf[3] = *(const GAS v4u*)(up_ + 192); CBAR(); }
#define PU_MMA(buf, key_) { const int p = (int)(key_ & 2047u), tl = p >> 7; const LAS unsigned char* xb = XQ + tl * PX_STR + F.wave * 512 + 16 * kg; \
              pg8::i32x4 acc = (pg8::i32x4){0, 0, 0, 0}; \
              _Pragma("unroll") for (int m = 0; m < 4; ++m) { const v4u uw = buf[m]; const pg8::i32x4 x0 = *(const LAS pg8::i32x4*)(xb + 128 * m), x1q = *(const LAS pg8::i32x4*)(xb + 128 * m + 64); \
                  const pg8::i32x4 alo = {(int)(uw.x & 0x0F0F0F0Fu), (int)(uw.y & 0x0F0F0F0Fu), (int)(uw.z & 0x0F0F0F0Fu), (int)(uw.w & 0x0F0F0F0Fu)}; \
                  const pg8::i32x4 ahi = {(int)((uw.x >> 4) & 0x0F0F0F0Fu), (int)((uw.y >> 4) & 0x0F0F0F0Fu), (int)((uw.z >> 4) & 0x0F0F0F0Fu), (int)((uw.w >> 4) & 0x0F0F0F0Fu)}; \
                  acc = __builtin_amdgcn_mfma_i32_16x16x64_i8(alo, x0, acc, 0, 0, 0); acc = __builtin_amdgcn_mfma_i32_16x16x64_i8(ahi, x1q, acc, 0, 0, 0); } \
              if (kg == (n >> 2)) { const int r = n & 3; const int ai = r == 0 ? acc[0] : r == 1 ? acc[1] : r == 2 ? acc[2] : acc[3];        \
                  const float a = (float)ai - 7.5f * (float)XS[tl * 8 + F.wave];                                                              \
                  __hip_atomic_fetch_add(ACT + p, a, __ATOMIC_RELAXED, __HIP_MEMORY_SCOPE_WORKGROUP); } }
            v4u ua[4], ubb[4], uc[4]; unsigned ka, kb2, kc;
            PU_LOAD(ua, ka, 0) PU_LOAD(ubb, kb2, 1)
#pragma unroll 1
            for (int gi = 0; gi < 126; gi += 3) {
                PU_LOAD(uc, kc, gi + 2) PU_MMA(ua, ka)
                PU_LOAD(ua, ka, gi + 3) PU_MMA(ubb, kb2)
                PU_LOAD(ubb, kb2, gi + 4) PU_MMA(uc, kc)
            }
            PU_MMA(ua, ka) PU_MMA(ubb, kb2)
#undef PU_LOAD
#undef PU_MMA
        }
        __syncthreads();
#pragma unroll
        for (int i = 0; i < 4; ++i) { const int p = tid + 512 * i; const int e = RE[p]; const float av = ACT[p] * SXI[p >> 7] * F.usc[e];
            ACT[p] = 0.5f * av * (1.f + erff(av * 0.70710678118654752f)) * RG[p] * F.usc[NEXP + e]; }
        __syncthreads();
#pragma unroll 1
        for (int tt = 0; tt < 2; ++tt) { const int tl = 2 * F.wave + tt; peer_token_v(F, tok0 + tl, tl, SKEY, ACT, WL, g2, lnf, x1); }
        __syncthreads();
    }
}
struct Args { const void* in[14]; float* out; unsigned char* ws; int ph_lo, ph_hi; };
__global__ void __launch_bounds__(NWAVES * 64, 2) fwd_kernel(Args args) {
    extern __shared__ __attribute__((aligned(16))) unsigned char lds_raw[];
    Frame F;
    F.lds = (LAS unsigned char*)lds_raw;
    F.MISC = (volatile LAS unsigned*)(F.lds + MISC_OFF);
    F.tid = threadIdx.x; F.lane = F.tid & 63; F.wave = __builtin_amdgcn_readfirstlane(F.tid >> 6); F.G = gridDim.x;
    unsigned char* ws = args.ws;
    F.ctl = (gu32*)(ws + WS_CTL);
    F.x = (const float*)args.in[0]; F.c = (const float*)args.in[1]; F.pos = (const int*)args.in[2]; F.ln1g = (const float*)args.in[3]; F.ln2g = (const float*)args.in[4];
    F.w_ada = (const float*)args.in[5]; F.b_ada = (const float*)args.in[6]; F.w_in = (const float*)args.in[7]; F.w_out = (const float*)args.in[8]; F.wq = (const float*)args.in[9];
    F.subk = (const float*)args.in[10]; F.pu = (const float*)args.in[11]; F.pv = (const float*)args.in[12]; F.lnfg = (const float*)args.in[13]; F.out = args.out;
    F.modp = (float*)(ws + WS_MODP); F.ropeH = (_Float16*)(ws + WS_COSH); F.ropeI = (_Float16*)(ws + WS_COSI);
    F.lse = (float*)(ws + WS_LSE); F.score = (float*)(ws + WS_SCORE); F.x1 = (bf16*)(ws + WS_X1);
    F.sk = (bf16*)(ws + WS_SK); F.win = (bf16*)(ws + WS_WIN); F.wout = (bf16*)(ws + WS_WOUT); F.wqt = (bf16*)(ws + WS_WQ); F.h = (bf16*)(ws + WS_H); F.reg = (int*)(ws + WS_H); F.rgg = (float*)(ws + WS_H + 4 * MiB); F.proj = (bf16*)(ws + WS_PROJ);
    F.oap = (bf16*)(ws + WS_OAP); F.o = (bf16*)(ws + WS_O); F.pq = (bf16*)(ws + WS_PQ); F.u8 = ws + WS_U16; F.v8 = ws + WS_V16; F.usc = (float*)(ws + WS_USC); F.h8 = (signed char*)(ws + WS_H8); F.wq8 = (signed char*)(ws + WS_WQ8); F.sah = (float*)(ws + WS_SAH); F.sbq = (float*)(ws + WS_SBQ); F.win8 = (signed char*)(ws + WS_WIN8); F.o8 = (signed char*)(ws + WS_O); F.wout8 = (signed char*)(ws + WS_WOUT8); F.sao = (float*)(ws + WS_SAO); F.sbo = (float*)(ws + WS_SBO); F.sbin = (float*)(ws + WS_SBIN);
    for (int u = F.tid; u < (LDS_BYTES - LDSCTL_OFF) / 4; u += NWAVES * 64) ((LAS unsigned*)(F.lds + LDSCTL_OFF))[u] = 0u;
    __syncthreads();
    XcdBarrier bar = xcd_barrier_post((unsigned*)(F.ctl + CW_BAR), F.MISC + 8);
    const int lo = args.ph_lo, hi = args.ph_hi;
#ifndef PHMASK
#define PHMASK 0x1ff
#endif
#define IN(k) (((PHMASK >> (k)) & 1) && lo <= (k) && (k) < hi)
#define SEAM(k) do { if (IN(k) && IN((k) + 1)) xcd_barrier(bar); } while (0)
#define FRESH_LANE() do { int l_ = (int)__builtin_amdgcn_mbcnt_hi(~0u, __builtin_amdgcn_mbcnt_lo(~0u, 0u)); asm volatile("" : "+v"(l_)); F.lane = l_; F.tid = F.wave * 64 + l_; } while (0)

    if (IN(0)) { FRESH_LANE(); p0_gemv(F); p0_items(F); }
    SEAM(0);
    if (IN(1)) {
#if MIX_ENABLE
        FRESH_LANE();
        modnorm_phase(F, F.x, F.ln1g, 0, 1, nullptr, F.h8, F.sah);
        { const int gw = blockIdx.x * NWAVES + F.wave, NGW = F.G * NWAVES;
          quant_rows_bf16_i8(F.win, F.win8, F.sbin, gw, NGW, PROJ_LD, F.lane); }
#endif
    }
    SEAM(1);
    if (IN(2)) {
#if MIX_ENABLE
        pg8::Gemm g{(const pg8::bf16_t*)F.h8, (const pg8::bf16_t*)F.win8, NTOK, PROJ_LD, DM / 2}; pg8::StaticOrder S; S.init(NTOK, PROJ_LD, F.G, (int)blockIdx.x);
        pg8::EpiProjI8 E{F.proj, PROJ_LD, F.ropeH, F.ropeI, F.sah, F.sbin};
        pg8::gemm_phase_i8<pg8::EpiProjI8, pg8::StaticOrder, true, true>(F.lds + RING_OFF, g, S, E);
        { const int nwg = (NTOK / 256) * (PROJ_LD / 256), rem = nwg % F.G; const int U7 = ROWS_IN_P4;
          if (rem != 0) { FRESH_LANE();
              const int nearly = (F.G - rem) * NWAVES, nslots = 2 * nearly + rem * NWAVES; const bool early = (int)blockIdx.x >= rem;
              const int s0 = early ? 2 * (((int)blockIdx.x - rem) * NWAVES + F.wave) : 2 * nearly + (int)blockIdx.x * NWAVES + F.wave;
              for (int ix = s0; ix < NITEMS_B - U7; ix += nslots) {
                  conv_item_b(F, ix < NEXP ? ix : ix + U7, (LAS float*)(F.lds + F.wave * 16640));
                  if (early && ix + 1 < NITEMS_B - U7) conv_item_b(F, ix + 1 < NEXP ? ix + 1 : ix + 1 + U7, (LAS float*)(F.lds + F.wave * 16640)); } }
          else if (rem == 0) { FRESH_LANE(); const int gw = blockIdx.x * NWAVES + F.wave, NGW = F.G * NWAVES; for (int ix = gw; ix < NITEMS_B - U7; ix += NGW) conv_item_b(F, ix < NEXP ? ix : ix + U7, (LAS float*)(F.lds + F.wave * 16640)); } }
#endif
    }
    SEAM(2);
    if (IN(3)) {
#if MIX_ENABLE
        FRESH_LANE();
        { gu32* ctr = F.ctl + 64; int u = p3_next(F, ctr);
          while (u < 320) { idx_unit(F, 319 - u); u = p3_next(F, ctr); }
          dil_units(F, u - 320, ctr, 1536); }
#endif
    }
    SEAM(3);
    if (IN(4)) {
#if MIX_ENABLE
        FRESH_LANE();
        const int gw = blockIdx.x * NWAVES + F.wave, NGW = F.G * NWAVES;
        LAS unsigned char* wl = F.lds + F.wave * DSA_WLDS;
        int k4 = 0;
        for (int i = gw; i < NTOK; i += NGW, ++k4) { FRESH_LANE(); const int b = i >> 12, r = i & (SEQ - 1); const int t = ((r ^ (r >> 2) ^ (r >> 11)) & 1) ? (SEQ - 1 - (r >> 1)) : (r >> 1); dsa_token(F, b, t, wl);
            { FRESH_LANE();
              for (int j = k4 * ROWS4_PER_TOK; j < (k4 + 1) * ROWS4_PER_TOK; ++j) { const int it = gw + j * NGW; if (it < ROWS_IN_P4) conv_item_b(F, NEXP + it, (LAS float*)nullptr); } } }
        { const int ktok = gw < NTOK ? (NTOK - gw + NGW - 1) / NGW : 0; for (int it = gw + ktok * ROWS4_PER_TOK * NGW; it < ROWS_IN_P4; it += NGW) conv_item_b(F, NEXP + it, (LAS float*)nullptr); }
        quant_rows_bf16_i8(F.wout, F.wout8, F.sbo, gw, NGW, DM, F.lane);
        __syncthreads();
#endif
    }
    SEAM(4);
    if (IN(5)) {
#if MIX_ENABLE
        pg8::Gemm g{(const pg8::bf16_t*)F.o8, (const pg8::bf16_t*)F.wout8, NTOK, DM, DM / 2}; pg8::StaticOrder S; S.init(NTOK, DM, F.G, (int)blockIdx.x);
        pg8::EpiResI8 E{F.x, (pg8::bf16_t*)F.x1, DM, F.modp, F.b_ada, 2 * DM, NADA, SEQ / 256, F.sao, F.sbo};
        pg8::gemm_phase_i8<pg8::EpiResI8, pg8::StaticOrder, true, true>(F.lds + RING_OFF, g, S, E);
#endif
    }
    SEAM(5);
    static_assert(MIX_ENABLE, "the residual stream after the mixers is the bf16 buffer x1");
    const bf16* x1 = F.x1;
    if (IN(6)) { FRESH_LANE(); modnorm_phase(F, x1, F.ln2g, 3, 4, nullptr, F.h8, F.sah);
        { const int gw = blockIdx.x * NWAVES + F.wave, NGW = F.G * NWAVES;
          quant_rows_bf16_i8(F.wqt, F.wq8, F.sbq, gw, NGW, PQ_LD, F.lane); } }
    SEAM(6);
    if (IN(7)) {
        pg8::Gemm g{(const pg8::bf16_t*)F.h8, (const pg8::bf16_t*)F.wq8, NTOK, PQ_LD, DM / 2}; pg8::StaticOrder S; S.init(NTOK, PQ_LD, F.G, (int)blockIdx.x);
        pg8::EpiStoreBf16I8 E{F.pq, PQ_LD, F.sah, F.sbq};
        pg8::gemm_phase_i8<pg8::EpiStoreBf16I8, pg8::StaticOrder, true, true>(F.lds + RING_OFF, g, S, E);
        asm volatile("s_waitcnt vmcnt(0)" ::: "memory"); __syncthreads();
        __builtin_amdgcn_fence(__ATOMIC_ACQUIRE, "workgroup");
        FRESH_LANE();
        for (int i = 0;; ++i) {
            constexpr int nM = NTOK / 256, nN = PQ_LD / 256, nwg = nM * nN; const long L = (long)i * F.G + (int)blockIdx.x; if (L >= nwg) break;
            int wgid = (int)L; { const int q = nwg / pg8::NXCD, r = nwg % pg8::NXCD, xcd = wgid % pg8::NXCD, off = wgid / pg8::NXCD; wgid = (xcd < r ? xcd * (q + 1) : r * (q + 1) + (xcd - r) * q) + off; }
            const int nig = pg8::WGM * nN, gid = wgid / nig, fm = gid * pg8::WGM, gsz = (nM - fm) < pg8::WGM ? (nM - fm) : pg8::WGM;
            route_tile(F, fm + ((wgid % nig) % gsz), (wgid % nig) / gsz); }
    }
    SEAM(7);
    if (IN(8)) { FRESH_LANE(); peer_phase(F, x1); }
#undef IN
#undef SEAM
}

#ifndef N_LAUNCHES
#define N_LAUNCHES 1
#endif
extern "C" void kernel_launch(void* const* d_in, const int* in_sizes, int n_in, void* d_out, int out_size, void* d_ws, size_t ws_size, hipStream_t stream) {
    static int grid = 0;
    if (grid == 0) {
        if (n_in != 14 || out_size != NTOK * DM || ws_size < WS_END) { fprintf(stderr, "kernel_launch: unexpected shapes (n_in %d, out %d, ws %zu)\n", n_in, out_size, ws_size); grid = -1; return; }
        int dev = 0, cus = 0, per_cu = 0;
        if (hipGetDevice(&dev) != hipSuccess || hipDeviceGetAttribute(&cus, hipDeviceAttributeMultiprocessorCount, dev) != hipSuccess) { grid = -1; return; }
        if (hipFuncSetAttribute((const void*)fwd_kernel, hipFuncAttributeMaxDynamicSharedMemorySize, LDS_BYTES) != hipSuccess) { fprintf(stderr, "kernel_launch: hipFuncSetAttribute failed\n"); grid = -1; return; }
        if (hipOccupancyMaxActiveBlocksPerMultiprocessor(&per_cu, (const void*)fwd_kernel, NWAVES * 64, LDS_BYTES) != hipSuccess || per_cu < 1) fprintf(stderr, "kernel_launch: occupancy query reports %d\n", per_cu);
        (void)hipGetLastError();
        grid = cus;
    }
    if (grid < 0) return;
    (void)hipMemsetAsync((char*)d_ws + WS_CTL, 0, CTL_ZERO_BYTES, stream);
    Args a{};
    for (int i = 0; i < 14; ++i) a.in[i] = d_in[i];
    a.out = (float*)d_out; a.ws = (unsigned char*)d_ws;
#if N_LAUNCHES == 1
    a.ph_lo = 0; a.ph_hi = 9;
    hipLaunchKernelGGL(fwd_kernel, dim3(grid), dim3(NWAVES * 64), LDS_BYTES, stream, a);
#ifdef PROBE_PHASE
    a.ph_lo = PROBE_PHASE; a.ph_hi = PROBE_PHASE + 1;
    hipLaunchKernelGGL(fwd_kernel, dim3(grid), dim3(NWAVES * 64), LDS_BYTES, stream, a);
#endif
#else
    for (int p = 0; p < 9; ++p) { a.ph_lo = p; a.ph_hi = p + 1; hipLaunchKernelGGL(fwd_kernel, dim3(grid), dim3(NWAVES * 64), LDS_BYTES, stream, a); }
#endif
}
```
